# Optimizing an MI355X kernel written in HIP

```python
import math
import jax
import jax.numpy as jnp
from jax import lax
import numpy as np

D_MODEL = 1024
BATCH = 2
SEQ = 8192
DEPTH = 1

GRID_W = 64
CTX_LEN = 256
N_HEADS = 8
HEAD_DIM = 64
V_DIM = 2 * HEAD_DIM
QK_W = N_HEADS * 2 * HEAD_DIM
ATT_W = N_HEADS * V_DIM
CONV_W = D_MODEL
CONV_K = 3
D_FF = 2816
N_MOD = 9
Q_BLOCK = 128
ROPE_BASE = 10000.0
AXIS_DIM = HEAD_DIM // 2
N_FREQ = AXIS_DIM // 2
EPS = 1e-6
Q_OFF = 0
K_OFF = Q_OFF + QK_W
V_OFF = K_OFF + QK_W
B_OFF = V_OFF + ATT_W
C_OFF = B_OFF + CONV_W
X_OFF = C_OFF + CONV_W
GA_OFF = X_OFF + CONV_W
GB_OFF = GA_OFF + D_MODEL
IN_W = GB_OFF + D_MODEL

kernel_name = "hybrid_diffattn_shortconv_macaron_dit_layer"


def rms_norm(x, g):
    xf = x.astype(jnp.float32)
    y = xf * lax.rsqrt(jnp.mean(xf * xf, axis=-1, keepdims=True) + EPS)
    return (y * g.astype(jnp.float32)).astype(x.dtype)


def modulate(x, shift, scale):
    return x * (1.0 + scale) + shift


def adaln(cond, w_mod, b_mod):
    m = jax.nn.silu(cond) @ w_mod + b_mod
    return jnp.split(m, N_MOD, axis=-1)


def swiglu(x, w_gate, w_up, w_down):
    return (jax.nn.silu(x @ w_gate) * (x @ w_up)) @ w_down


def ffn_sublayer(h, mods, pre_g, post_g, w_gate, w_up, w_down):
    shift, scale, gate = mods
    y = swiglu(modulate(rms_norm(h, pre_g), shift, scale), w_gate, w_up, w_down)
    return h + 0.5 * gate * rms_norm(y, post_g)


def axial_rope_tables(n, dtype):
    n_rows = n // GRID_W
    row = jnp.repeat(jnp.arange(n_rows, dtype=jnp.float32), GRID_W)
    col = jnp.tile(jnp.arange(GRID_W, dtype=jnp.float32), n_rows)
    inv_freq = ROPE_BASE ** (-2.0 * jnp.arange(N_FREQ, dtype=jnp.float32) / AXIS_DIM)
    ang = jnp.stack([row, col], axis=-1)[:, :, None] * inv_freq
    ang = jnp.stack([ang, ang], axis=-2).reshape(n, HEAD_DIM)
    return jnp.cos(ang).astype(dtype), jnp.sin(ang).astype(dtype)


def apply_rope(x, cos, sin):
    xs = x.reshape(x.shape[:-1] + (2, 2, N_FREQ))
    rot = jnp.stack([-xs[..., 1, :], xs[..., 0, :]], axis=-2).reshape(x.shape)
    return x * cos[None, :, None, None, :] + rot * sin[None, :, None, None, :]


def diff_attend(q, k, v, lam):
    s = jnp.einsum('bqhmd,bkhmd->bhmqk', q, k, preferred_element_type=jnp.float32) * (HEAD_DIM ** -0.5)
    p = jax.nn.softmax(s, axis=-1)
    a = p[:, :, 0] - lam * p[:, :, 1]
    return jnp.einsum('bhqk,bkhe->bqhe', a.astype(v.dtype), v)


def blocked_diff_attention(q, k, v, lam):
    b, n = q.shape[:2]
    nb = n // Q_BLOCK
    qb = q.reshape((b, nb, Q_BLOCK) + q.shape[2:]).swapaxes(0, 1)
    ob = lax.map(lambda qi: diff_attend(qi, k, v, lam), qb)
    return ob.swapaxes(0, 1).reshape(b, n, N_HEADS, V_DIM)


def short_conv(z, w):
    L = z.shape[1]
    pad = CONV_K // 2
    zp = jnp.pad(z, ((0, 0), (pad, pad), (0, 0)))
    return sum(zp[:, j:j + L] * w[j] for j in range(CONV_K))


def split_kv(u_kv):
    b, L = u_kv.shape[:2]
    k = u_kv[..., :QK_W].reshape(b, L, N_HEADS, 2, HEAD_DIM)
    v = u_kv[..., QK_W:].reshape(b, L, N_HEADS, V_DIM)
    return k, v


def diff_lambda(lq1, lk1, lq2, lk2, lam_init):
    f = jnp.float32
    return (jnp.exp(jnp.sum(lq1.astype(f) * lk1.astype(f)))
            - jnp.exp(jnp.sum(lq2.astype(f) * lk2.astype(f))) + lam_init)


def token_mixer(u, ext_k, ext_v, rope, lam, lam_init, subln_g, conv_w, w_pa, w_pb, w_o):
    b, L, _ = u.shape
    q = u[..., Q_OFF:K_OFF].reshape(b, L, N_HEADS, 2, HEAD_DIM)
    k, v = split_kv(u[..., K_OFF:B_OFF])
    if rope is not None:
        cos, sin = rope
        q = apply_rope(q, cos, sin)
        k = apply_rope(k, cos, sin)
    if ext_k is not None:
        k = jnp.concatenate([ext_k, k], axis=1)
        v = jnp.concatenate([ext_v, v], axis=1)
    o = blocked_diff_attention(q, k, v, lam)
    o = rms_norm(o, subln_g) * (1.0 - lam_init)
    y_att = o.reshape(b, L, ATT_W) @ w_pa
    gate_b = u[..., B_OFF:C_OFF]
    gate_c = u[..., C_OFF:X_OFF]
    x_in = u[..., X_OFF:GA_OFF]
    y_conv = (gate_b * short_conv(gate_c * x_in, conv_w)) @ w_pb
    merged = (jax.nn.sigmoid(u[..., GA_OFF:GB_OFF]) * y_att
              + jax.nn.sigmoid(u[..., GB_OFF:IN_W]) * y_conv)
    return merged @ w_o


def setup_inputs(seed: int = 0) -> dict:
    key = jax.random.key(seed)
    ks = jax.random.split(key, 32)
    L = DEPTH

    def nrm(k, shape, scale):
        return scale * jax.random.normal(k, shape, jnp.float32)

    def gain(k, shape):
        return 1.0 + 0.02 * jax.random.normal(k, shape, jnp.float32)

    d_s = D_MODEL ** -0.5
    f_s = D_FF ** -0.5
    return {
        "x": nrm(ks[0], (BATCH, SEQ, D_MODEL), 1.0),
        "c": nrm(ks[1], (BATCH, D_MODEL), 1.0),
        "ctx": nrm(ks[2], (BATCH, CTX_LEN, D_MODEL), 1.0),
        "c_ctx": nrm(ks[3], (D_MODEL,), 1.0),
        "w_mod": nrm(ks[4], (L, D_MODEL, N_MOD * D_MODEL), 0.5 * d_s),
        "b_mod": nrm(ks[5], (L, N_MOD * D_MODEL), 0.02),
        "ffn1_pre_g": gain(ks[6], (L, D_MODEL)),
        "ffn1_post_g": gain(ks[7], (L, D_MODEL)),
        "ffn1_w_gate": nrm(ks[8], (L, D_MODEL, D_FF), d_s),
        "ffn1_w_up": nrm(ks[9], (L, D_MODEL, D_FF), d_s),
        "ffn1_w_down": nrm(ks[10], (L, D_FF, D_MODEL), f_s),
        "mix_pre_g": gain(ks[11], (L, D_MODEL)),
        "mix_post_g": gain(ks[12], (L, D_MODEL)),
        "w_in": nrm(ks[13], (L, D_MODEL, IN_W), d_s),
        "lam_q1": nrm(ks[14], (L, HEAD_DIM), 0.1),
        "lam_k1": nrm(ks[15], (L, HEAD_DIM), 0.1),
        "lam_q2": nrm(ks[16], (L, HEAD_DIM), 0.1),
        "lam_k2": nrm(ks[17], (L, HEAD_DIM), 0.1),
        "attn_subln_g": gain(ks[18], (L, V_DIM)),
        "conv_w": nrm(ks[19], (L, CONV_K, CONV_W), CONV_K ** -0.5),
        "w_attn_proj": nrm(ks[20], (L, ATT_W, D_MODEL), ATT_W ** -0.5),
        "w_conv_proj": nrm(ks[21], (L, CONV_W, D_MODEL), CONV_W ** -0.5),
        "w_out": nrm(ks[22], (L, D_MODEL, D_MODEL), d_s),
        "ffn2_pre_g": gain(ks[23], (L, D_MODEL)),
        "ffn2_post_g": gain(ks[24], (L, D_MODEL)),
        "ffn2_w_gate": nrm(ks[25], (L, D_MODEL, D_FF), d_s),
        "ffn2_w_up": nrm(ks[26], (L, D_MODEL, D_FF), d_s),
        "ffn2_w_down": nrm(ks[27], (L, D_FF, D_MODEL), f_s),
    }


def reference(x, c, ctx, c_ctx, w_mod, b_mod,
              ffn1_pre_g, ffn1_post_g, ffn1_w_gate, ffn1_w_up, ffn1_w_down,
              mix_pre_g, mix_post_g, w_in, lam_q1, lam_k1, lam_q2, lam_k2,
              attn_subln_g, conv_w, w_attn_proj, w_conv_proj, w_out,
              ffn2_pre_g, ffn2_post_g, ffn2_w_gate, ffn2_w_up, ffn2_w_down):
    n = x.shape[1]
    rope = axial_rope_tables(n, x.dtype)
    h, hc = x, ctx
    for l in range(DEPTH):
        last = l == DEPTH - 1
        ml = [t[:, None, :] for t in adaln(c, w_mod[l], b_mod[l])]
        mc = adaln(c_ctx, w_mod[l], b_mod[l])

        ffn1 = (ffn1_pre_g[l], ffn1_post_g[l], ffn1_w_gate[l], ffn1_w_up[l], ffn1_w_down[l])
        h = ffn_sublayer(h, ml[0:3], *ffn1)
        hc = ffn_sublayer(hc, mc[0:3], *ffn1)

        lam_init = 0.8 - 0.6 * math.exp(-0.3 * l)
        lam = diff_lambda(lam_q1[l], lam_k1[l], lam_q2[l], lam_k2[l], lam_init)
        mix = (lam, lam_init, attn_subln_g[l], conv_w[l], w_attn_proj[l], w_conv_proj[l], w_out[l])
        xmc = modulate(rms_norm(hc, mix_pre_g[l]), mc[3], mc[4])
        if last:
            u_kv_c = xmc @ w_in[l][:, K_OFF:B_OFF]
        else:
            uc = xmc @ w_in[l]
            u_kv_c = uc[..., K_OFF:B_OFF]
            yc = token_mixer(uc, None, None, None, *mix)
            hc_mixed = hc + mc[5] * rms_norm(yc, mix_post_g[l])
        k_c, v_c = split_kv(u_kv_c)
        xm = modulate(rms_norm(h, mix_pre_g[l]), ml[3], ml[4])
        y = token_mixer(xm @ w_in[l], k_c, v_c, rope, *mix)
        h = h + ml[5] * rms_norm(y, mix_post_g[l])

        ffn2 = (ffn2_pre_g[l], ffn2_post_g[l], ffn2_w_gate[l], ffn2_w_up[l], ffn2_w_down[l])
        h = ffn_sublayer(h, ml[6:9], *ffn2)
        if not last:
            hc = ffn_sublayer(hc_mixed, mc[6:9], *ffn2)
    return h
```

```cpp
#include <hip/hip_runtime.h>
#include <hip/hip_cooperative_groups.h>
#include <cstdio>
#include <cstdint>
namespace cg = cooperative_groups;

#define LAS __attribute__((address_space(3)))
typedef unsigned short bf16_t;
typedef short bf16x8 __attribute__((ext_vector_type(8)));
typedef short s16x4 __attribute__((ext_vector_type(4)));
typedef float f32x4 __attribute__((ext_vector_type(4)));
typedef float f32x2 __attribute__((ext_vector_type(2)));
typedef float f32x16 __attribute__((ext_vector_type(16)));
typedef unsigned u32x4 __attribute__((ext_vector_type(4)));
typedef unsigned u32x2 __attribute__((ext_vector_type(2)));

constexpr int DM = 1024, SEQ = 8192, NB = 2, CTXL = 256, FF = 2816, INW = 8192;
constexpr int ML = NB * SEQ;
constexpr int MC = NB * CTXL;
constexpr int MT = ML + MC;
constexpr int NKV = SEQ + CTXL;
constexpr int NMOD = 9 * DM;
constexpr float EPS = 1e-6f;
constexpr float LAM_INIT = 0.2f;

constexpr size_t MiB = 1u << 20;
constexpr size_t WS_MODS = 64 * 1024;
constexpr size_t WS_ROPE = 256 * 1024;
constexpr size_t WS_WGU1 = 1 * MiB;
constexpr size_t WS_WD1  = 12 * MiB;
constexpr size_t WS_WGU2 = 18 * MiB;
constexpr size_t WS_WD2  = 29 * MiB;
constexpr size_t WS_WIN  = 35 * MiB;
constexpr size_t WS_WPA  = 51 * MiB, WS_WPB = 53 * MiB, WS_WOUT = 55 * MiB;
constexpr size_t WS_Y1   = 57 * MiB;
constexpr size_t WS_R1   = 90 * MiB;
constexpr size_t WS_R2   = 123 * MiB;
constexpr size_t WS_HID  = WS_R2;
constexpr size_t WS_Q    = WS_R2;
constexpr size_t WS_K    = WS_R2 + 32 * MiB;
constexpr size_t WS_V    = WS_R2 + 65 * MiB;
constexpr size_t WS_O    = WS_R2 + 99 * MiB;
constexpr size_t WS_BG   = WS_R2;
constexpr size_t WS_Z    = WS_R2 + 32 * MiB;
constexpr size_t WS_GA   = WS_R2 + 64 * MiB;
constexpr size_t WS_Y3   = WS_R2 + 96 * MiB;
static_assert(WS_O + 32 * MiB <= 256 * MiB, "ws map");

typedef __bf16 bf16x2_t __attribute__((ext_vector_type(2)));
__device__ __forceinline__ unsigned cvt_pk_bf16(float lo, float hi) { f32x2 v = {lo, hi}; bf16x2_t b = __builtin_convertvector(v, bf16x2_t); return __builtin_bit_cast(unsigned, b); }
__device__ __forceinline__ float bf_lo(unsigned w) { return __uint_as_float(w << 16); }
__device__ __forceinline__ float bf_hi(unsigned w) { return __uint_as_float(w & 0xffff0000u); }
__device__ __forceinline__ float fast_sigmoid(float x) { return __builtin_amdgcn_rcpf(1.0f + __builtin_amdgcn_exp2f(-1.4426950408889634f * x)); }

namespace pg8 {
constexpr int BM = 256, BK = 64, HALF = 128, HTB = HALF * BK * 2, STAGE_BYTES = 8 * HTB, NXCD = 8, WGM = 8;
__host__ __device__ __forceinline__ int lds_byte(int r, int c) { const int st = (r >> 4) * 2 + (c >> 5), rr = r & 15, cc = c & 31, ob = rr * 64 + cc * 2; return st * 1024 + (ob ^ (((ob >> 9) & 1) << 5)); }
__host__ __device__ __forceinline__ void stage_rc(int b, int& R, int& C) { const int st = b / 1024, sb = b % 1024, swz = sb ^ (((sb >> 9) & 1) << 5); R = (st >> 1) * 16 + swz / 64; C = (st & 1) * 32 + (swz % 64) / 2; }
__host__ __device__ __forceinline__ int perm32(int rho) { const int n = rho >> 4, i = rho & 15; return 8 * (i >> 2) + 4 * n + (i & 3); }

struct Unit { int pm, pn; };
struct Gemm { const bf16_t* A; const bf16_t* Bt; int M, N, K; };

struct StaticOrder {
    int nM, nN, nwg, G, c;
    __device__ void init(int M, int N, int G_, int c_) { nM = M / BM; nN = N / BM; nwg = nM * nN; G = G_; c = c_; }
    __device__ bool map(long L, Unit& u) const {
        if (L >= nwg) return false;
        int wgid = (int)L; { const int q = nwg / NXCD, r = nwg % NXCD, xcd = wgid % NXCD, off = wgid / NXCD; wgid = (xcd < r ? xcd * (q + 1) : r * (q + 1) + (xcd - r) * q) + off; }
        const int nig = WGM * nN, gid = wgid / nig, fm = gid * WGM, gsz = (nM - fm) < WGM ? (nM - fm) : WGM;
        u.pm = fm + ((wgid % nig) % gsz); u.pn = (wgid % nig) / gsz; return true;
    }
    __device__ bool next(int i, Unit& u) const { return map((long)i * G + c, u); }
};
struct CtxGUOrder  { int c; __device__ bool next(int i, Unit& u) const { if (i > 0 || c < 8 || c >= 52) return false; const int e = c - 8; u.pm = 64 + (e & 1); u.pn = e >> 1; return true; } };
struct CtxDownOrder { int c; __device__ bool next(int i, Unit& u) const { if (i > 0 || c >= 8) return false; u.pm = 64 + (c >> 2); u.pn = c & 3; return true; } };
struct CtxKVOrder  { int c; __device__ bool next(int i, Unit& u) const { if (i > 0 || c >= 16) return false; u.pm = 64 + (c >> 3); u.pn = 4 + (c & 7); return true; } };
struct LatGUOrder { StaticOrder S; int c;
    __device__ bool next(int i, Unit& u) const { long L;
        if (i < 3) L = (long)i * 256 + c; else if (i < 5) { if (c < 8) return false; L = 768 + (long)(i - 3) * 248 + (c - 8); } else if (i == 5) { if (c < 52) return false; L = 1264 + (c - 52); } else return false;
        return S.map(L, u); } };
typedef f32x4 Acc[2][2][4][2];

__device__ __forceinline__ u32x4 pack8(f32x4 a, f32x4 b) { u32x4 w; w.x = cvt_pk_bf16(a[0], a[1]); w.y = cvt_pk_bf16(a[2], a[3]); w.z = cvt_pk_bf16(b[0], b[1]); w.w = cvt_pk_bf16(b[2], b[3]); return w; }

struct EpiPlain {
    static constexpr bool PERM = true;
    bf16_t* O; int ldc;
    __device__ __forceinline__ void operator()(const Acc& acc, const Unit& u, int wr, int wc, int fr, int fq) const {
        const int row0 = u.pm * BM + wr * 64 + fr, col0 = u.pn * BM + wc * 32 + 8 * fq;
#pragma unroll
        for (int ai = 0; ai < 2; ++ai)
#pragma unroll
            for (int m = 0; m < 4; ++m) { bf16_t* rowp = O + (size_t)(row0 + ai * HALF + m * 16) * ldc + col0;
#pragma unroll
                for (int bj = 0; bj < 2; ++bj) *(u32x4*)(rowp + bj * HALF) = pack8(acc[ai][bj][m][0], acc[ai][bj][m][1]); }
    }
};
struct EpiSwiGLU {
    static constexpr bool PERM = true;
    bf16_t* O; int ldc;
    __device__ __forceinline__ void operator()(const Acc& acc, const Unit& u, int wr, int wc, int fr, int fq) const {
        const int row0 = u.pm * BM + wr * 64 + fr, col0 = u.pn * HALF + wc * 32 + 8 * fq;
#pragma unroll
        for (int ai = 0; ai < 2; ++ai)
#pragma unroll
            for (int m = 0; m < 4; ++m) { bf16_t* rowp = O + (size_t)(row0 + ai * HALF + m * 16) * ldc + col0;
                f32x4 h[2];
#pragma unroll
                for (int n = 0; n < 2; ++n)
#pragma unroll
                    for (int i = 0; i < 4; ++i) { const float g = acc[ai][0][m][n][i], up = acc[ai][1][m][n][i]; h[n][i] = g * fast_sigmoid(g) * up; }
                *(u32x4*)rowp = pack8(h[0], h[1]); }
    }
};
struct EpiQKV {
    static constexpr bool PERM = true;
    bf16_t *Q, *Kb, *Vb; const f32x2* rope;
    __device__ __forceinline__ void operator()(const Acc& acc, const Unit& u, int wr, int wc, int fr, int fq) const {
        const int pn = u.pn;
#pragma unroll
        for (int ai = 0; ai < 2; ++ai)
#pragma unroll
            for (int m = 0; m < 4; ++m) {
                const int row = u.pm * BM + ai * HALF + wr * 64 + m * 16 + fr;
                const bool ctx = row >= ML;
                int t, kvrow;
                if (!ctx) { const int b = row >> 13; t = row & (SEQ - 1); kvrow = b * NKV + CTXL + t; }
                else { const int rc = row - ML, b = rc >> 8; t = rc & (CTXL - 1); kvrow = b * NKV + t; }
                if (pn < 8) {
                    const int hh = wc >> 1, mm = wc & 1, axis = fq >> 1, f0 = 8 * (fq & 1);
                    const int col = (2 * (pn & 3) + hh) * 128 + mm * 64 + axis * 32 + f0;
                    f32x4 x0a = acc[ai][0][m][0], x0b = acc[ai][0][m][1], x1a = acc[ai][1][m][0], x1b = acc[ai][1][m][1];
                    if (pn < 4) { constexpr float QS = 0.125f * 1.4426950408889634f; x0a = x0a * QS; x0b = x0b * QS; x1a = x1a * QS; x1b = x1b * QS; }
                    if (!ctx) {
                        const int pos = axis ? (t & 63) : (t >> 6);
                        const f32x4* rp = (const f32x4*)(rope + pos * 16 + f0);
                        const f32x4 c01 = rp[0], c23 = rp[1], c45 = rp[2], c67 = rp[3];
                        f32x4 o0a, o0b, o1a, o1b;
                        o0a[0] = x0a[0] * c01[0] - x1a[0] * c01[1]; o1a[0] = x1a[0] * c01[0] + x0a[0] * c01[1];
                        o0a[1] = x0a[1] * c01[2] - x1a[1] * c01[3]; o1a[1] = x1a[1] * c01[2] + x0a[1] * c01[3];
                        o0a[2] = x0a[2] * c23[0] - x1a[2] * c23[1]; o1a[2] = x1a[2] * c23[0] + x0a[2] * c23[1];
                        o0a[3] = x0a[3] * c23[2] - x1a[3] * c23[3]; o1a[3] = x1a[3] * c23[2] + x0a[3] * c23[3];
                        o0b[0] = x0b[0] * c45[0] - x1b[0] * c45[1]; o1b[0] = x1b[0] * c45[0] + x0b[0] * c45[1];
                        o0b[1] = x0b[1] * c45[2] - x1b[1] * c45[3]; o1b[1] = x1b[1] * c45[2] + x0b[1] * c45[3];
                        o0b[2] = x0b[2] * c67[0] - x1b[2] * c67[1]; o1b[2] = x1b[2] * c67[0] + x0b[2] * c67[1];
                        o0b[3] = x0b[3] * c67[2] - x1b[3] * c67[3]; o1b[3] = x1b[3] * c67[2] + x0b[3] * c67[3];
                        x0a = o0a; x0b = o0b; x1a = o1a; x1b = o1b;
                    }
                    bf16_t* dst = (pn < 4) ? (Q + (size_t)row * DM) : (Kb + (size_t)kvrow * DM);
                    if (pn >= 4 || !ctx) { *(u32x4*)(dst + col) = pack8(x0a, x0b); *(u32x4*)(dst + col + 16) = pack8(x1a, x1b); }
                } else {
                    bf16_t* dst = Vb + (size_t)kvrow * DM + (pn - 8) * BM + wc * 32 + 8 * fq;
#pragma unroll
                    for (int bj = 0; bj < 2; ++bj) *(u32x4*)(dst + bj * HALF) = pack8(acc[ai][bj][m][0], acc[ai][bj][m][1]);
                }
            }
    }
};
struct EpiRest {
    static constexpr bool PERM = true;
    bf16_t *Bg, *Z, *GA, *GB;
    __device__ __forceinline__ void operator()(const Acc& acc, const Unit& u, int wr, int wc, int fr, int fq) const {
        const int pn = u.pn, row0 = u.pm * BM + wr * 64 + fr, cin = wc * 32 + 8 * fq;
#pragma unroll
        for (int ai = 0; ai < 2; ++ai)
#pragma unroll
            for (int m = 0; m < 4; ++m) { const size_t ro = (size_t)(row0 + ai * HALF + m * 16) * DM;
                if (pn >= 4 && pn < 12) {
                    *(u32x4*)(Z + ro + (pn - 4) * HALF + cin) = pack8(acc[ai][0][m][0] * acc[ai][1][m][0], acc[ai][0][m][1] * acc[ai][1][m][1]);
                } else if (pn < 4) {
#pragma unroll
                    for (int bj = 0; bj < 2; ++bj) *(u32x4*)(Bg + ro + pn * BM + bj * HALF + cin) = pack8(acc[ai][bj][m][0], acc[ai][bj][m][1]);
                } else {
                    bf16_t* G = (pn < 16) ? GA : GB; const int ct = (pn < 16) ? pn - 12 : pn - 16;
#pragma unroll
                    for (int bj = 0; bj < 2; ++bj) { f32x4 s[2];
#pragma unroll
                        for (int n = 0; n < 2; ++n)
#pragma unroll
                            for (int i = 0; i < 4; ++i) s[n][i] = fast_sigmoid(acc[ai][bj][m][n][i]);
                        *(u32x4*)(G + ro + ct * BM + bj * HALF + cin) = pack8(s[0], s[1]); }
                }
            }
    }
};
template <int MODE> struct EpiGate {
    static constexpr bool PERM = true;
    bf16_t *GA, *GB;
    __device__ __forceinline__ void operator()(const Acc& acc, const Unit& u, int wr, int wc, int fr, int fq) const {
        const int row0 = u.pm * BM + wr * 64 + fr, col0 = u.pn * BM + wc * 32 + 8 * fq;
#pragma unroll
        for (int ai = 0; ai < 2; ++ai)
#pragma unroll
            for (int m = 0; m < 4; ++m) { const size_t ro = (size_t)(row0 + ai * HALF + m * 16) * DM + col0;
#pragma unroll
                for (int bj = 0; bj < 2; ++bj) {
                    const u32x4 ga = *(const u32x4*)(GA + ro + bj * HALF);
                    const f32x4 a0 = acc[ai][bj][m][0], a1 = acc[ai][bj][m][1];
                    f32x4 r0, r1;
                    if (MODE == 0) {
                        r0[0] = bf_lo(ga.x) * a0[0]; r0[1] = bf_hi(ga.x) * a0[1]; r0[2] = bf_lo(ga.y) * a0[2]; r0[3] = bf_hi(ga.y) * a0[3];
                        r1[0] = bf_lo(ga.z) * a1[0]; r1[1] = bf_hi(ga.z) * a1[1]; r1[2] = bf_lo(ga.w) * a1[2]; r1[3] = bf_hi(ga.w) * a1[3];
                        *(u32x4*)(GA + ro + bj * HALF) = pack8(r0, r1);
                    } else {
                        const u32x4 gb = __builtin_nontemporal_load((const u32x4*)(GB + ro + bj * HALF));
                        r0[0] = bf_lo(ga.x) + bf_lo(gb.x) * a0[0]; r0[1] = bf_hi(ga.x) + bf_hi(gb.x) * a0[1]; r0[2] = bf_lo(ga.y) + bf_lo(gb.y) * a0[2]; r0[3] = bf_hi(ga.y) + bf_hi(gb.y) * a0[3];
                        r1[0] = bf_lo(ga.z) + bf_lo(gb.z) * a1[0]; r1[1] = bf_hi(ga.z) + bf_hi(gb.z) * a1[1]; r1[2] = bf_lo(ga.w) + bf_lo(gb.w) * a1[2]; r1[3] = bf_hi(ga.w) + bf_hi(gb.w) * a1[3];
                        *(u32x4*)(GB + ro + bj * HALF) = pack8(r0, r1);
                    }
                } }
    }
};

template <class Epi, class Sched, bool ALIGN_EPI = true, bool SP2 = true>
__device__ __forceinline__ void gemm_phase(LAS unsigned char* lds, const Gemm g, const Sched& S, const Epi& E) {
    int tid_ = threadIdx.x; asm volatile("" : "+v"(tid_));
    const int tid = tid_, wid = __builtin_amdgcn_readfirstlane(tid >> 6), lane = tid & 63, wr = wid >> 2, wc = wid & 3, fr = lane & 15, fq = lane >> 4;
    const int K = g.K, nt = K / BK;
    unsigned voffA[2], voffB[2];
#pragma unroll
    for (int i = 0; i < 2; ++i) { int R, C; stage_rc(tid * 16 + i * 8192, R, C); const int Rb = Epi::PERM ? ((R & ~31) + perm32(R & 31)) : R;
        voffA[i] = (unsigned)(R * K + C) * 2u; voffB[i] = (unsigned)(Rb * K + C) * 2u; }
    const size_t kstep = (size_t)(BK * 2);
    const size_t hstep = (size_t)HALF * K * 2;
    const size_t tstep = 2 * hstep;
    const unsigned ldsw = (unsigned)wid * 1024u;
    const int aoff = lds_byte(wr * 64 + fr, fq * 8), boff = lds_byte(wc * 32 + fr, fq * 8);
#define PG8_SA(b, h) (((b) * 2 + (h)) * HTB)
#define PG8_SB(b, h) ((4 + (b) * 2 + (h)) * HTB)
#define PG8_STAGE(bufoff, gbase, voff) do { _Pragma("unroll") for (int _i = 0; _i < 2; ++_i) \
        __builtin_amdgcn_global_load_lds((const unsigned*)((const char*)(gbase) + (voff)[_i]), (LAS unsigned*)(lds + (bufoff) + ldsw + _i * 8192), 16, 0, 0); } while (0)
#define PG8_LDA(dst, b, h) do { _Pragma("unroll") for (int m = 0; m < 4; ++m) _Pragma("unroll") for (int k = 0; k < 2; ++k) dst[m][k] = *(const LAS bf16x8*)(lds + PG8_SA(b, h) + aoff + m * 2048 + k * 1024); } while (0)
#define PG8_LDB(dst, b, h) do { _Pragma("unroll") for (int n = 0; n < 2; ++n) _Pragma("unroll") for (int k = 0; k < 2; ++k) dst[n][k] = *(const LAS bf16x8*)(lds + PG8_SB(b, h) + boff + n * 2048 + k * 1024); } while (0)
#define PG8_MMA(ai, bj, At, Bt) do { __builtin_amdgcn_s_setprio(1); _Pragma("unroll") for (int m = 0; m < 4; ++m) _Pragma("unroll") for (int n = 0; n < 2; ++n) _Pragma("unroll") for (int k = 0; k < 2; ++k) \
        acc[ai][bj][m][n] = __builtin_amdgcn_mfma_f32_16x16x32_bf16(Bt[n][k], At[m][k], acc[ai][bj][m][n], 0, 0, 0); __builtin_amdgcn_s_setprio(0); } while (0)
#define PG8_WAIT_V(n) asm volatile("s_waitcnt vmcnt(" #n ")" ::: "memory")
#define PG8_WAIT_L(n) asm volatile("s_waitcnt lgkmcnt(" #n ")" ::: "memory")
#define PG8_BAR __builtin_amdgcn_s_barrier()
#define PG8_SCHED __builtin_amdgcn_sched_barrier(0)
    Unit cur, nxt; int ui = 0;
    if (!S.next(0, cur)) return;
    f32x4 acc[2][2][4][2];
#pragma unroll
    for (int a = 0; a < 2; ++a)
#pragma unroll
        for (int b = 0; b < 2; ++b)
#pragma unroll
            for (int m = 0; m < 4; ++m)
#pragma unroll
                for (int n = 0; n < 2; ++n) acc[a][b][m][n] = (f32x4){0.f, 0.f, 0.f, 0.f};
    bf16x8 At[4][2], B0[2][2], B1[2][2];
    const char* cA = (const char*)g.A + (size_t)cur.pm * tstep; const char* cB = (const char*)g.Bt + (size_t)cur.pn * tstep;
    if constexpr (SP2) {
        PG8_STAGE(PG8_SB(0, 0), cB, voffB); PG8_STAGE(PG8_SB(0, 1), cB + hstep, voffB); PG8_STAGE(PG8_SA(0, 0), cA, voffA); PG8_STAGE(PG8_SA(0, 1), cA + hstep, voffA);
        if (wr == 1) PG8_BAR;
        PG8_WAIT_V(2); PG8_BAR;
        PG8_STAGE(PG8_SB(1, 0), cB + kstep, voffB); PG8_STAGE(PG8_SA(1, 0), cA + kstep, voffA); PG8_STAGE(PG8_SB(1, 1), cB + hstep + kstep, voffB);
        PG8_WAIT_V(6); PG8_BAR;
    } else {
        PG8_STAGE(PG8_SB(0, 0), cB, voffB); PG8_STAGE(PG8_SA(0, 0), cA, voffA); PG8_STAGE(PG8_SB(0, 1), cB + hstep, voffB); PG8_STAGE(PG8_SA(0, 1), cA + hstep, voffA);
        if (wr == 1) PG8_BAR;
        PG8_WAIT_V(4); PG8_BAR;
        PG8_STAGE(PG8_SB(1, 0), cB + kstep, voffB); PG8_STAGE(PG8_SA(1, 0), cA + kstep, voffA); PG8_STAGE(PG8_SB(1, 1), cB + hstep + kstep, voffB);
        PG8_WAIT_V(6); PG8_BAR;
    }
    for (;;) {
        const bool has_next = S.next(ui + 1, nxt);
        const char* nA = has_next ? (const char*)g.A + (size_t)nxt.pm * tstep : cA; const char* nB = has_next ? (const char*)g.Bt + (size_t)nxt.pn * tstep : cB;
        for (int t = 0; t < nt; t += 2) {
            const bool last = (t == nt - 2);
            const char* a1 = cA + (size_t)(t + 1) * kstep;
            const char* a2 = last ? nA : cA + (size_t)(t + 2) * kstep; const char* b2 = last ? nB : cB + (size_t)(t + 2) * kstep;
            const char* a3 = a2 + kstep; const char* b3 = b2 + kstep;
            if constexpr (SP2) {
            PG8_LDB(B0, 0, 0); PG8_LDB(B1, 0, 1); PG8_SCHED; PG8_LDA(At, 0, 0); PG8_STAGE(PG8_SA(1, 1), a1 + hstep, voffA);
            PG8_WAIT_V(8); PG8_WAIT_L(0); PG8_BAR; PG8_MMA(0, 0, At, B0); PG8_MMA(0, 1, At, B1); PG8_BAR; PG8_SCHED;
            PG8_LDA(At, 0, 1); PG8_STAGE(PG8_SB(0, 0), b2, voffB); PG8_STAGE(PG8_SB(0, 1), b2 + hstep, voffB); PG8_STAGE(PG8_SA(0, 0), a2, voffA);
            PG8_WAIT_V(8); PG8_WAIT_L(0); PG8_BAR; PG8_MMA(1, 0, At, B0); PG8_MMA(1, 1, At, B1); PG8_BAR; PG8_SCHED;
            PG8_LDB(B0, 1, 0); PG8_LDB(B1, 1, 1); PG8_SCHED; PG8_LDA(At, 1, 0); PG8_STAGE(PG8_SA(0, 1), a2 + hstep, voffA);
            PG8_WAIT_V(8); PG8_WAIT_L(0); PG8_BAR; PG8_MMA(0, 0, At, B0); PG8_MMA(0, 1, At, B1); PG8_BAR; PG8_SCHED;
            PG8_LDA(At, 1, 1); PG8_STAGE(PG8_SB(1, 0), b3, voffB); PG8_STAGE(PG8_SB(1, 1), b3 + hstep, voffB); PG8_STAGE(PG8_SA(1, 0), a3, voffA);
            PG8_WAIT_V(8); PG8_WAIT_L(0); PG8_BAR; PG8_MMA(1, 0, At, B0); PG8_MMA(1, 1, At, B1); PG8_BAR; PG8_SCHED;
            } else {
            PG8_LDB(B0, 0, 0); PG8_SCHED; PG8_LDA(At, 0, 0); PG8_STAGE(PG8_SA(1, 1), a1 + hstep, voffA);
            PG8_WAIT_L(8); PG8_BAR; PG8_WAIT_L(0); PG8_MMA(0, 0, At, B0); PG8_BAR; PG8_SCHED;
            PG8_LDB(B1, 0, 1); PG8_STAGE(PG8_SB(0, 0), b2, voffB);
            PG8_BAR; PG8_WAIT_L(0); PG8_MMA(0, 1, At, B1); PG8_BAR;
            PG8_LDA(At, 0, 1); PG8_STAGE(PG8_SA(0, 0), a2, voffA);
            PG8_BAR; PG8_WAIT_L(0); PG8_MMA(1, 0, At, B0); PG8_BAR; PG8_SCHED;
            PG8_STAGE(PG8_SB(0, 1), b2 + hstep, voffB);
            PG8_WAIT_V(6); PG8_BAR; PG8_MMA(1, 1, At, B1); PG8_BAR;
            PG8_LDB(B0, 1, 0); PG8_SCHED; PG8_LDA(At, 1, 0); PG8_STAGE(PG8_SA(0, 1), a2 + hstep, voffA);
            PG8_WAIT_L(8); PG8_BAR; PG8_WAIT_L(0); PG8_MMA(0, 0, At, B0); PG8_BAR; PG8_SCHED;
            PG8_LDB(B1, 1, 1); PG8_STAGE(PG8_SB(1, 0), b3, voffB);
            PG8_BAR; PG8_WAIT_L(0); PG8_MMA(0, 1, At, B1); PG8_BAR;
            PG8_LDA(At, 1, 1); PG8_STAGE(PG8_SA(1, 0), a3, voffA);
            PG8_BAR; PG8_WAIT_L(0); PG8_MMA(1, 0, At, B0); PG8_BAR; PG8_SCHED;
            PG8_STAGE(PG8_SB(1, 1), b3 + hstep, voffB);
            PG8_WAIT_V(6); PG8_BAR; PG8_MMA(1, 1, At, B1); PG8_BAR;
            }
        }
        if constexpr (ALIGN_EPI) { if (wr == 0) PG8_BAR; }
        E(acc, cur, wr, wc, fr, fq);
        if (!has_next) break;
#pragma unroll
        for (int a = 0; a < 2; ++a)
#pragma unroll
            for (int b = 0; b < 2; ++b)
#pragma unroll
                for (int m = 0; m < 4; ++m)
#pragma unroll
                    for (int n = 0; n < 2; ++n) acc[a][b][m][n] = (f32x4){0.f, 0.f, 0.f, 0.f};
        cur = nxt; cA = nA; cB = nB; ++ui;
        if constexpr (ALIGN_EPI) { if (wr == 1) PG8_BAR; }
    }
    PG8_WAIT_V(0);
    if constexpr (!ALIGN_EPI) { if (wr == 0) PG8_BAR; }
    PG8_BAR;
#undef PG8_SA
#undef PG8_SB
#undef PG8_STAGE
#undef PG8_LDA
#undef PG8_LDB
#undef PG8_MMA
#undef PG8_WAIT_V
#undef PG8_WAIT_L
#undef PG8_BAR
#undef PG8_SCHED
}
}

namespace att {
constexpr int NW = 8, QBLK = 32, KVBLK = 64, LD = 1024, NT = NKV / KVBLK;
constexpr int SHM_V = KVBLK * 128 * 2, SHM_K = KVBLK * 64 * 2;
constexpr int NSLOT = 3, OFF_V = 0, OFF_K = NSLOT * SHM_V, OFF_WS = OFF_K + NSLOT * SHM_K, OFF_ST = OFF_WS + NW * 64 * 4, LDS_BYTES = OFF_ST + NW * 32 * 64 * 4;
constexpr float SCALE = 0.125f, THR = 8.f;
#define SBAR() __builtin_amdgcn_sched_barrier(0)
__device__ __forceinline__ int crow(int r, int hi) { return (r & 3) + 8 * (r >> 2) + 4 * hi; }

__device__ __forceinline__ void qkt(f32x16& p0, f32x16& p1, const char* Ks, const bf16x8* qr, int r32, int hi) {
  p0 = f32x16{}; p1 = f32x16{};
#pragma unroll
  for (int d0 = 0; d0 < 4; ++d0) { const char* kb = Ks + (2 * d0 + hi) * 1024 + r32 * 16;
    bf16x8 b0 = *reinterpret_cast<const bf16x8*>(kb);
    bf16x8 b1 = *reinterpret_cast<const bf16x8*>(kb + 512);
    p0 = __builtin_amdgcn_mfma_f32_32x32x16_bf16(b0, qr[d0], p0, 0, 0, 0);
    p1 = __builtin_amdgcn_mfma_f32_32x32x16_bf16(b1, qr[d0], p1, 0, 0, 0); }
}
__device__ __forceinline__ void glds16(const void* gsrc, unsigned lds_dst) { unsigned keep;
  asm volatile("s_mov_b32 %0, m0\n\ts_mov_b32 m0, %2\n\ts_nop 0\n\tglobal_load_lds_dwordx4 %1, off\n\ts_mov_b32 m0, %0" : "=&s"(keep) : "v"(gsrc), "s"(lds_dst) : "memory"); }
__device__ __forceinline__ int v_rd_base(int lane) { return ((lane & 3) << 3) | (((lane >> 2) & 3) << 6) | (((lane >> 4) & 1) << 5) | (((lane >> 5) & 1) << 8); }
constexpr int v_rd_off(int d0, int ks, int half) { return d0 * 512 + ks * 4096 + half * 2048; }
template <int OFF> __device__ __forceinline__ s16x4 tr_read(int vb) {
  s16x4 r; asm volatile("ds_read_b64_tr_b16 %0, %1 offset:%2" : "=&v"(r) : "v"(vb), "i"(OFF) : "memory"); return r;
}
#define PKV(L, H) (bf16x8){L[0], L[1], L[2], L[3], H[0], H[1], H[2], H[3]}
template <int D0> __device__ __forceinline__ void rd8(int vb, s16x4 (&l)[4], s16x4 (&h)[4]) {
  l[0] = tr_read<v_rd_off(D0, 0, 0)>(vb); h[0] = tr_read<v_rd_off(D0, 0, 1)>(vb); l[1] = tr_read<v_rd_off(D0, 1, 0)>(vb); h[1] = tr_read<v_rd_off(D0, 1, 1)>(vb);
  l[2] = tr_read<v_rd_off(D0, 2, 0)>(vb); h[2] = tr_read<v_rd_off(D0, 2, 1)>(vb); l[3] = tr_read<v_rd_off(D0, 3, 0)>(vb); h[3] = tr_read<v_rd_off(D0, 3, 1)>(vb);
}
__device__ __forceinline__ void mm4(f32x16& od, const s16x4 (&l)[4], const s16x4 (&h)[4], bf16x8 pa0, bf16x8 pa1, bf16x8 pa2, bf16x8 pa3) {
  od = __builtin_amdgcn_mfma_f32_32x32x16_bf16(pa0, PKV(l[0], h[0]), od, 0, 0, 0);
  od = __builtin_amdgcn_mfma_f32_32x32x16_bf16(pa1, PKV(l[1], h[1]), od, 0, 0, 0);
  od = __builtin_amdgcn_mfma_f32_32x32x16_bf16(pa2, PKV(l[2], h[2]), od, 0, 0, 0);
  od = __builtin_amdgcn_mfma_f32_32x32x16_bf16(pa3, PKV(l[3], h[3]), od, 0, 0, 0);
}
__device__ __forceinline__ void pv_d0(f32x16* o, int vb, bf16x8 pa0, bf16x8 pa1, bf16x8 pa2, bf16x8 pa3) {
  s16x4 la[4], ha[4], lb[4], hb[4];
  rd8<0>(vb, la, ha); rd8<1>(vb, lb, hb);
  asm volatile("s_waitcnt lgkmcnt(8)" ::: "memory"); SBAR();
  mm4(o[0], la, ha, pa0, pa1, pa2, pa3); SBAR();
  rd8<2>(vb, la, ha);
  asm volatile("s_waitcnt lgkmcnt(8)" ::: "memory"); SBAR();
  mm4(o[1], lb, hb, pa0, pa1, pa2, pa3); SBAR();
  rd8<3>(vb, lb, hb);
  asm volatile("s_waitcnt lgkmcnt(8)" ::: "memory"); SBAR();
  mm4(o[2], la, ha, pa0, pa1, pa2, pa3); SBAR();
  asm volatile("s_waitcnt lgkmcnt(0)" ::: "memory"); SBAR();
  mm4(o[3], lb, hb, pa0, pa1, pa2, pa3);
}

#define PK4(P, BASE, OUT) do { unsigned a0 = cvt_pk_bf16(P[BASE + 0], P[BASE + 1]), a1 = cvt_pk_bf16(P[BASE + 2], P[BASE + 3]);   \
    unsigned b0 = cvt_pk_bf16(P[BASE + 4], P[BASE + 5]), b1 = cvt_pk_bf16(P[BASE + 6], P[BASE + 7]);                              \
    auto r0 = __builtin_amdgcn_permlane32_swap(a0, b0, false, false); auto r1 = __builtin_amdgcn_permlane32_swap(a1, b1, false, false); \
    u32x4 w = {r0[0], r1[0], r0[1], r1[1]}; OUT = *reinterpret_cast<bf16x8*>(&w); } while (0)
template <int I> __device__ __forceinline__ void finA(const f32x16& P0, const f32x16& P1, float& ps0, float& ps1, unsigned (&cv)[4], bf16x8& pa0, bf16x8& pa1, bf16x8& pa2, bf16x8& pa3) {
  if constexpr (I < 4) { ps0 += P0[4 * I]; ps1 += P0[4 * I + 1]; ps0 += P0[4 * I + 2]; ps1 += P0[4 * I + 3]; }
  else { ps0 += P1[4 * (I - 4)]; ps1 += P1[4 * (I - 4) + 1]; ps0 += P1[4 * (I - 4) + 2]; ps1 += P1[4 * (I - 4) + 3]; }
#define CV4(P, B) do { cv[0] = cvt_pk_bf16(P[B + 0], P[B + 1]); cv[1] = cvt_pk_bf16(P[B + 2], P[B + 3]); cv[2] = cvt_pk_bf16(P[B + 4], P[B + 5]); cv[3] = cvt_pk_bf16(P[B + 6], P[B + 7]); \
    asm volatile("" : "+v"(cv[0]), "+v"(cv[1]), "+v"(cv[2]), "+v"(cv[3])); } while (0)
#define SW2(OUT) do { auto r0 = __builtin_amdgcn_permlane32_swap(cv[0], cv[2], false, false); auto r1 = __builtin_amdgcn_permlane32_swap(cv[1], cv[3], false, false); \
    u32x4 w = {r0[0], r1[0], r0[1], r1[1]}; OUT = *reinterpret_cast<bf16x8*>(&w); asm volatile("" : "+v"(OUT)); } while (0)
  if constexpr (I == 0) CV4(P0, 0);
  if constexpr (I == 1) SW2(pa0);
  if constexpr (I == 2) CV4(P0, 8);
  if constexpr (I == 3) SW2(pa1);
  if constexpr (I == 4) CV4(P1, 0);
  if constexpr (I == 5) SW2(pa2);
  if constexpr (I == 6) CV4(P1, 8);
  if constexpr (I == 7) SW2(pa3);
#undef CV4
#undef SW2
  asm volatile("" : "+v"(ps0), "+v"(ps1));
}
template <int I> __device__ __forceinline__ void expB(f32x16& C0, f32x16& C1) {
  if constexpr (I < 8) { C0[2 * I] = __builtin_amdgcn_exp2f(C0[2 * I]); C0[2 * I + 1] = __builtin_amdgcn_exp2f(C0[2 * I + 1]); asm volatile("" : "+v"(C0)); }
  else { C1[2 * (I - 8)] = __builtin_amdgcn_exp2f(C1[2 * (I - 8)]); C1[2 * (I - 8) + 1] = __builtin_amdgcn_exp2f(C1[2 * (I - 8) + 1]); asm volatile("" : "+v"(C1)); }
}
__device__ __forceinline__ float rowmax16(const f32x16& p) {
  float a = fmaxf(fmaxf(p[0], p[1]), p[2]), b = fmaxf(fmaxf(p[3], p[4]), p[5]);
  a = fmaxf(fmaxf(a, p[6]), p[7]); b = fmaxf(fmaxf(b, p[8]), p[9]);
  a = fmaxf(fmaxf(a, p[10]), p[11]); b = fmaxf(fmaxf(b, p[12]), p[13]);
  a = fmaxf(fmaxf(a, p[14]), p[15]);
  return fmaxf(a, b);
}
__device__ __forceinline__ void rowdecide(float pm0, f32x16& p0, f32x16& p1, f32x16& negm, float& alpha) {
  constexpr float THRL = THR * 1.4426950408889634f;
  float pmax = fmaxf(pm0, rowmax16(p1));
  { auto rr = __builtin_amdgcn_permlane32_swap(__float_as_uint(pmax), __float_as_uint(pmax), false, false);
    pmax = fmaxf(__uint_as_float(rr[0]), __uint_as_float(rr[1])); }
  alpha = 1.f;
  if (__builtin_expect(__any(pmax > THRL), 0)) {
    const float dl = fmaxf(pmax, 0.f);
#pragma unroll
    for (int r = 0; r < 16; ++r) { p0[r] -= dl; p1[r] -= dl; negm[r] -= dl; }
    asm volatile("" : "+v"(negm));
    alpha = __builtin_amdgcn_exp2f(-dl);
  }
}
template <int mp, int ABL = 0> __device__ __forceinline__ void attn_map(int b, int h, int qb, const bf16_t* __restrict__ Q, const bf16_t* __restrict__ K, const bf16_t* __restrict__ V,
                                          bf16_t* __restrict__ O, const float* __restrict__ subln_g, float lam, char* lds) {
  int tid_ = threadIdx.x; asm volatile("" : "+v"(tid_));
  const int tid = tid_, wid = __builtin_amdgcn_readfirstlane(tid >> 6), lane = tid & 63, r32 = lane & 31, hi = lane >> 5;
  char* V_lds = lds + OFF_V; char* K_lds = lds + OFF_K;
  float* ws = (float*)(lds + OFF_WS) + wid * 64; float* li_l = ws; float* al_l = ws + 32;
  unsigned* stash = (unsigned*)(lds + OFF_ST) + wid * 32 * 64 + lane;
  const unsigned lds0 = (unsigned)(uintptr_t)lds;
  const unsigned ko0 = (unsigned)(lane * LD + wid * 8) * 2u;
  unsigned vo0, vo1;
  { const int kkl = (lane >> 2) & 7, cl = 32 * (lane >> 5) + (lane & 3) * 8;
    const int kk0 = 8 * (wid >> 1) + kkl, kk1 = 8 * ((wid + 8) >> 1) + kkl;
    const int key0 = (kk0 & ~0xC) | ((kk0 & 4) << 1) | ((kk0 & 8) >> 1), key1 = (kk1 & ~0xC) | ((kk1 & 4) << 1) | ((kk1 & 8) >> 1);
    vo0 = (unsigned)(key0 * LD + 64 * (wid & 1) + cl) * 2u; vo1 = (unsigned)(key1 * LD + 64 * (wid & 1) + cl) * 2u; }
  const int vb0 = (int)(uintptr_t)V_lds + v_rd_base(lane);
  const size_t qrow0 = (size_t)b * SEQ + (size_t)qb * 256 + wid * QBLK;
  const bf16_t* Vh = V + (size_t)b * NKV * LD + h * 128;
  {
    const bf16_t* Kh = K + (size_t)b * NKV * LD + h * 128 + mp * 64;
    const bf16_t* Qw = Q + (qrow0 + r32) * LD + h * 128 + mp * 64 + hi * 8;
    float l_reg = 0; f32x16 o[4] = {}; bf16x8 qr[4]; float nz_ = 0.f; asm volatile("" : "+v"(nz_)); f32x16 negm; _Pragma("unroll") for (int r = 0; r < 16; ++r) negm[r] = nz_; asm volatile("" : "+v"(negm));
#pragma unroll
    for (int d0 = 0; d0 < 4; ++d0) qr[d0] = __builtin_nontemporal_load(reinterpret_cast<const bf16x8*>(Qw + d0 * 16));
#define DMA(t, slot) do { if constexpr (ABL & 4) break; const char* vt_ = (const char*)Vh + (size_t)(t) * (KVBLK * LD * 2); const char* kt_ = (const char*)Kh + (size_t)(t) * (KVBLK * LD * 2); \
    glds16(kt_ + ko0, (unsigned)__builtin_amdgcn_readfirstlane(lds0 + OFF_K + (slot) * SHM_K + wid * 1024)); \
    glds16(vt_ + vo0, (unsigned)__builtin_amdgcn_readfirstlane(lds0 + OFF_V + (slot) * SHM_V + wid * 1024)); \
    glds16(vt_ + vo1, (unsigned)__builtin_amdgcn_readfirstlane(lds0 + OFF_V + (slot) * SHM_V + (wid + 8) * 1024)); } while (0)
#define WAIT_BAR() asm volatile("s_waitcnt vmcnt(0) lgkmcnt(0)\n\ts_barrier" ::: "memory")
#define RESC(a) do { if (__any((a) < 1.f)) { if (hi == 0) al_l[r32] = (a); asm volatile("s_waitcnt lgkmcnt(0)" ::: "memory"); \
    _Pragma("unroll") for (int d = 0; d < 4; ++d) _Pragma("unroll") for (int r = 0; r < 16; ++r) o[d][r] *= al_l[crow(r, hi)]; } } while (0)
    f32x16 pA0, pA1, pB0, pB1; float alA, alB; bf16x8 pa0, pa1, pa2, pa3;
    int sp = 0, sc_ = 1, sn = 2;
#define ROT() do { const int t_ = sp; sp = sc_; sc_ = sn; sn = t_; } while (0)
#define MF(A_, B_, C_) ((ABL & 2) ? (C_) : __builtin_amdgcn_mfma_f32_32x32x16_bf16(A_, B_, C_, 0, 0, 0))
#define VR(I, L_, H_) do { L_ = tr_read<v_rd_off((I) / 4, (I) % 4, 0)>(vb_); H_ = tr_read<v_rd_off((I) / 4, (I) % 4, 1)>(vb_); } while (0)
#define LDK(D0, H) (*reinterpret_cast<const bf16x8*>(Kp_ + (2 * (D0) + hi) * 1024 + (H) * 512))
#define FINA(I, P0, P1) finA<I>(P0, P1, ps0, ps1, cv_, pa0, pa1, pa2, pa3)
#define STEP(C0, C1, P0, P1, ALP, ALC, DMA_STMT) do { \
      DMA_STMT; \
      const char* Kp_ = K_lds + sc_ * SHM_K + r32 * 16; float ps0 = 0.f, ps1 = 0.f; unsigned cv_[4]; \
      bf16x8 ka0 = LDK(0, 0), ka1 = LDK(0, 1), kb0, kb1; \
      SBAR(); \
      C0 = MF(ka0, qr[0], negm); kb0 = LDK(1, 0); kb1 = LDK(1, 1); FINA(0, P0, P1); SBAR(); \
      C1 = MF(ka1, qr[0], negm); FINA(1, P0, P1); SBAR(); \
      C0 = MF(kb0, qr[1], C0); ka0 = LDK(2, 0); ka1 = LDK(2, 1); FINA(2, P0, P1); SBAR(); \
      C1 = MF(kb1, qr[1], C1); FINA(3, P0, P1); SBAR(); \
      C0 = MF(ka0, qr[2], C0); kb0 = LDK(3, 0); kb1 = LDK(3, 1); FINA(4, P0, P1); SBAR(); \
      C1 = MF(ka1, qr[2], C1); FINA(5, P0, P1); SBAR(); \
      C0 = MF(kb0, qr[3], C0); FINA(6, P0, P1); SBAR(); \
      C1 = MF(kb1, qr[3], C1); FINA(7, P0, P1); float pm0_ = rowmax16(C0); asm volatile("" : "+v"(pm0_)); SBAR(); \
      { float ps = ps0 + ps1; auto rr = __builtin_amdgcn_permlane32_swap(__float_as_uint(ps), __float_as_uint(ps), false, false); \
        ps = __uint_as_float(rr[0]) + __uint_as_float(rr[1]); l_reg = l_reg * (ALP) + ps; } \
      SBAR(); \
      rowdecide(pm0_, C0, C1, negm, ALC); \
      const int vb_ = vb0 + sp * SHM_V; s16x4 vl0, vh0, vl1, vh1, vl2, vh2; \
      VR(0, vl0, vh0); VR(1, vl1, vh1); \
      VR(2, vl2, vh2); asm volatile("s_waitcnt lgkmcnt(4)" ::: "memory"); SBAR(); o[0] = MF(pa0, PKV(vl0, vh0), o[0]); if constexpr (!(ABL & 1)) expB<0>(C0, C1); SBAR(); \
      VR(3, vl0, vh0); asm volatile("s_waitcnt lgkmcnt(4)" ::: "memory"); SBAR(); o[0] = MF(pa1, PKV(vl1, vh1), o[0]); if constexpr (!(ABL & 1)) expB<1>(C0, C1); SBAR(); \
      VR(4, vl1, vh1); asm volatile("s_waitcnt lgkmcnt(4)" ::: "memory"); SBAR(); o[0] = MF(pa2, PKV(vl2, vh2), o[0]); if constexpr (!(ABL & 1)) expB<2>(C0, C1); SBAR(); \
      VR(5, vl2, vh2); asm volatile("s_waitcnt lgkmcnt(4)" ::: "memory"); SBAR(); o[0] = MF(pa3, PKV(vl0, vh0), o[0]); if constexpr (!(ABL & 1)) expB<3>(C0, C1); SBAR(); \
      VR(6, vl0, vh0); asm volatile("s_waitcnt lgkmcnt(4)" ::: "memory"); SBAR(); o[1] = MF(pa0, PKV(vl1, vh1), o[1]); if constexpr (!(ABL & 1)) expB<4>(C0, C1); SBAR(); \
      VR(7, vl1, vh1); asm volatile("s_waitcnt lgkmcnt(4)" ::: "memory"); SBAR(); o[1] = MF(pa1, PKV(vl2, vh2), o[1]); if constexpr (!(ABL & 1)) expB<5>(C0, C1); SBAR(); \
      VR(8, vl2, vh2); asm volatile("s_waitcnt lgkmcnt(4)" ::: "memory"); SBAR(); o[1] = MF(pa2, PKV(vl0, vh0), o[1]); if constexpr (!(ABL & 1)) expB<6>(C0, C1); SBAR(); \
      VR(9, vl0, vh0); asm volatile("s_waitcnt lgkmcnt(4)" ::: "memory"); SBAR(); o[1] = MF(pa3, PKV(vl1, vh1), o[1]); if constexpr (!(ABL & 1)) expB<7>(C0, C1); SBAR(); \
      VR(10, vl1, vh1); asm volatile("s_waitcnt lgkmcnt(4)" ::: "memory"); SBAR(); o[2] = MF(pa0, PKV(vl2, vh2), o[2]); if constexpr (!(ABL & 1)) expB<8>(C0, C1); SBAR(); \
      VR(11, vl2, vh2); asm volatile("s_waitcnt lgkmcnt(4)" ::: "memory"); SBAR(); o[2] = MF(pa1, PKV(vl0, vh0), o[2]); if constexpr (!(ABL & 1)) expB<9>(C0, C1); SBAR(); \
      VR(12, vl0, vh0); asm volatile("s_waitcnt lgkmcnt(4)" ::: "memory"); SBAR(); o[2] = MF(pa2, PKV(vl1, vh1), o[2]); if constexpr (!(ABL & 1)) expB<10>(C0, C1); SBAR(); \
      VR(13, vl1, vh1); asm volatile("s_waitcnt lgkmcnt(4)" ::: "memory"); SBAR(); o[2] = MF(pa3, PKV(vl2, vh2), o[2]); if constexpr (!(ABL & 1)) expB<11>(C0, C1); SBAR(); \
      VR(14, vl2, vh2); asm volatile("s_waitcnt lgkmcnt(4)" ::: "memory"); SBAR(); o[3] = MF(pa0, PKV(vl0, vh0), o[3]); if constexpr (!(ABL & 1)) expB<12>(C0, C1); SBAR(); \
      VR(15, vl0, vh0); asm volatile("s_waitcnt lgkmcnt(4)" ::: "memory"); SBAR(); o[3] = MF(pa1, PKV(vl1, vh1), o[3]); if constexpr (!(ABL & 1)) expB<13>(C0, C1); SBAR(); \
      asm volatile("s_waitcnt lgkmcnt(2)" ::: "memory"); SBAR(); o[3] = MF(pa2, PKV(vl2, vh2), o[3]); if constexpr (!(ABL & 1)) expB<14>(C0, C1); SBAR(); \
      asm volatile("s_waitcnt lgkmcnt(0)" ::: "memory"); SBAR(); o[3] = MF(pa3, PKV(vl0, vh0), o[3]); if constexpr (!(ABL & 1)) expB<15>(C0, C1); SBAR(); \
    } while (0)
    if (wid >= 4) __builtin_amdgcn_s_setprio(1);
    DMA(0, 0); DMA(1, 1); WAIT_BAR();
    { qkt(pA0, pA1, K_lds, qr, r32, hi); rowdecide(rowmax16(pA0), pA0, pA1, negm, alA);
#pragma unroll
      for (int r = 0; r < 16; ++r) { pA0[r] = __builtin_amdgcn_exp2f(pA0[r]); pA1[r] = __builtin_amdgcn_exp2f(pA1[r]); } }
    for (int j = 1; j + 1 < NT; j += 2) {
      STEP(pB0, pB1, pA0, pA1, alA, alB, DMA(j + 1, sn));
      RESC(alB); WAIT_BAR(); ROT();
      STEP(pA0, pA1, pB0, pB1, alB, alA, DMA(j + 2, sn));
      RESC(alA); WAIT_BAR(); ROT();
    }
    STEP(pB0, pB1, pA0, pA1, alA, alB, (void)0);
    RESC(alB);
    { float ps0 = 0.f, ps1 = 0.f; unsigned cv_[4];
      FINA(0, pB0, pB1); FINA(1, pB0, pB1); FINA(2, pB0, pB1); FINA(3, pB0, pB1); FINA(4, pB0, pB1); FINA(5, pB0, pB1); FINA(6, pB0, pB1); FINA(7, pB0, pB1);
      float ps = ps0 + ps1; auto rr = __builtin_amdgcn_permlane32_swap(__float_as_uint(ps), __float_as_uint(ps), false, false);
      ps = __uint_as_float(rr[0]) + __uint_as_float(rr[1]); l_reg = l_reg * alB + ps; }
    SBAR();
    pv_d0(o, vb0 + sc_ * SHM_V, pa0, pa1, pa2, pa3);
#undef STEP
#undef FINA
#undef LDK
#undef VR
#undef MF
#undef ROT
    __builtin_amdgcn_s_setprio(0);
    if (hi == 0) li_l[r32] = l_reg; asm volatile("s_waitcnt lgkmcnt(0)" ::: "memory");
    float rli[16];
#pragma unroll
    for (int r = 0; r < 16; ++r) rli[r] = __builtin_amdgcn_rcpf(li_l[crow(r, hi)]);
    if (mp == 0) {
#pragma unroll
      for (int d0 = 0; d0 < 4; ++d0)
#pragma unroll
        for (int r = 0; r < 16; r += 2) stash[(d0 * 8 + (r >> 1)) * 64] = cvt_pk_bf16(o[d0][r] * rli[r], o[d0][r + 1] * rli[r + 1]);
    } else {
      float ss[16];
#pragma unroll
      for (int r = 0; r < 16; ++r) ss[r] = 0.f;
#pragma unroll
      for (int d0 = 0; d0 < 4; ++d0)
#pragma unroll
        for (int r = 0; r < 16; r += 2) { const unsigned w = stash[(d0 * 8 + (r >> 1)) * 64];
          const float a0 = bf_lo(w) - lam * (o[d0][r] * rli[r]), a1 = bf_hi(w) - lam * (o[d0][r + 1] * rli[r + 1]);
          o[d0][r] = a0; o[d0][r + 1] = a1; ss[r] += a0 * a0; ss[r + 1] += a1 * a1; }
#pragma unroll
      for (int r = 0; r < 16; ++r) { float s = ss[r];
        s += __shfl_xor(s, 1); s += __shfl_xor(s, 2); s += __shfl_xor(s, 4); s += __shfl_xor(s, 8); s += __shfl_xor(s, 16);
        ss[r] = (1.0f - LAM_INIT) / sqrtf(s * (1.0f / 128.0f) + EPS); }
      bf16_t* stg = (bf16_t*)(lds + OFF_ST) + wid * 4096;
#pragma unroll
      for (int d0 = 0; d0 < 4; ++d0) { const float g = subln_g[d0 * 32 + r32];
#pragma unroll
        for (int r = 0; r < 16; ++r) { const unsigned w = cvt_pk_bf16(o[d0][r] * ss[r] * g, 0.f);
          stg[crow(r, hi) * 128 + d0 * 32 + r32] = (bf16_t)(w & 0xffffu); } }
      asm volatile("s_waitcnt lgkmcnt(0)" ::: "memory");
      const char* ob = (const char*)(O + qrow0 * LD + h * 128);
      const unsigned lo = (unsigned)((lane >> 4) * LD + (lane & 15) * 8) * 2u;
#pragma unroll
      for (int i = 0; i < 8; ++i) { const u32x4 v = *(const u32x4*)(stg + (i * 4 + (lane >> 4)) * 128 + (lane & 15) * 8); *(u32x4*)((char*)ob + lo) = v; ob += 4 * LD * 2; }
    }
    __syncthreads();
#undef DMA
#undef WAIT_BAR
#undef RESC
  }
}
__device__ __forceinline__ void attn_unit(int b, int h, int qb, const bf16_t* __restrict__ Q, const bf16_t* __restrict__ K, const bf16_t* __restrict__ V,
                                          bf16_t* __restrict__ O, bf16_t* __restrict__ O2, const float* __restrict__ subln_g, float lam, char* lds) {
  attn_map<0>(b, h, qb, Q, K, V, O, subln_g, lam, lds);
  attn_map<1>(b, h, qb, Q, K, V, O, subln_g, lam, lds);
}
#undef SBAR
}

constexpr int NWAVES = 8, NTHREADS = 512;
constexpr int LDS_BYTES = 147456;
static_assert(att::LDS_BYTES <= LDS_BYTES, "attention LDS");

struct Args {
    const float *x, *c, *ctx, *c_ctx, *w_mod, *b_mod;
    const float *f1_pre, *f1_post, *f1_wg, *f1_wu, *f1_wd;
    const float *mix_pre, *mix_post, *w_in, *lq1, *lk1, *lq2, *lk2, *subln, *conv_w, *w_pa, *w_pb, *w_out;
    const float *f2_pre, *f2_post, *f2_wg, *f2_wu, *f2_wd;
    float* out; unsigned char* ws;
};

__device__ __forceinline__ float wave_sum(float v) {
#pragma unroll
    for (int o = 1; o < 64; o <<= 1) v += __shfl_xor(v, o);
    return v;
}

template <int MAP> __device__ __forceinline__ int wmap(int n) {
    if (MAP == 0) return n;
    if (MAP == 1) return (n >> 7) * 256 + (n & 127);
    if (MAP == 2) return (n >> 7) * 256 + 128 + (n & 127);
    if (n < 2048) { const int rb = n & ~1023, w = n & 1023, head = w >> 7, mm = (w >> 6) & 1, axis = (w >> 5) & 1, half = (w >> 4) & 1, f = w & 15;
        return rb + (head >> 1) * 256 + half * 128 + (head & 1) * 64 + mm * 32 + axis * 16 + f; }
    if (n < 4096) return n;
    if (n < 5120) { const int ch = n - 4096; return 4096 + (ch >> 7) * 256 + (ch & 127); }
    if (n < 6144) { const int ch = n - 5120; return 4096 + (ch >> 7) * 256 + 128 + (ch & 127); }
    return n;
}
template <int MAP> __device__ __forceinline__ void transpose_item(const float* W, int K, int N, bf16_t* WT, LAS float* scr, int item, int lane) {
    const int nblk = N / 32, kb = item / nblk, nb = item % nblk, k0 = 64 * kb, n0 = 32 * nb;
#pragma unroll 8
    for (int i = 0; i < 32; ++i) { const int kk = 2 * i + (lane >> 5); scr[kk * 33 + (lane & 31)] = __builtin_nontemporal_load(W + (size_t)(k0 + kk) * N + n0 + (lane & 31)); }
    asm volatile("s_waitcnt lgkmcnt(0)" ::: "memory");
    const int c = lane & 7;
#pragma unroll
    for (int j = 0; j < 4; ++j) { const int n = (lane >> 3) + 8 * j; const LAS float* s = scr + (8 * c) * 33 + n;
        u32x4 o; o.x = cvt_pk_bf16(s[0 * 33], s[1 * 33]); o.y = cvt_pk_bf16(s[2 * 33], s[3 * 33]); o.z = cvt_pk_bf16(s[4 * 33], s[5 * 33]); o.w = cvt_pk_bf16(s[6 * 33], s[7 * 33]);
        *(u32x4*)(WT + (size_t)wmap<MAP>(n0 + n) * K + k0 + 8 * c) = o; }
    asm volatile("s_waitcnt lgkmcnt(0)" ::: "memory");
}

__device__ __forceinline__ void load_row_f32(const float* p, int lane, f32x4 (&v)[4]) {
#pragma unroll
    for (int j = 0; j < 4; ++j) v[j] = __builtin_nontemporal_load((const f32x4*)(p + 4 * lane + 256 * j));
}
__device__ __forceinline__ void store_row_f32(float* p, int lane, const f32x4 (&v)[4]) {
#pragma unroll
    for (int j = 0; j < 4; ++j) *(f32x4*)(p + 4 * lane + 256 * j) = v[j];
}
__device__ __forceinline__ void load_row_bf16(const bf16_t* p, int lane, f32x4 (&v)[4]) {
#pragma unroll
    for (int j = 0; j < 4; ++j) { const u32x2 w = __builtin_nontemporal_load((const u32x2*)(p + 4 * lane + 256 * j)); v[j] = (f32x4){bf_lo(w.x), bf_hi(w.x), bf_lo(w.y), bf_hi(w.y)}; }
}
__device__ __forceinline__ void store_row_bf16(bf16_t* p, int lane, const f32x4 (&v)[4]) {
#pragma unroll
    for (int j = 0; j < 4; ++j) { u32x2 w; w.x = cvt_pk_bf16(v[j][0], v[j][1]); w.y = cvt_pk_bf16(v[j][2], v[j][3]); *(u32x2*)(p + 4 * lane + 256 * j) = w; }
}
__device__ __forceinline__ float row_rstd(const f32x4 (&v)[4]) {
    float s = 0.f;
#pragma unroll
    for (int j = 0; j < 4; ++j) s += (v[j][0] * v[j][0] + v[j][1] * v[j][1]) + (v[j][2] * v[j][2] + v[j][3] * v[j][3]);
    return 1.0f / sqrtf(wave_sum(s) * (1.0f / DM) + EPS);
}
__device__ __forceinline__ void add_branch(f32x4 (&h)[4], const f32x4 (&y)[4], float coef, const float* gate, const float* g, int lane) {
    const float r = row_rstd(y) * coef;
#pragma unroll
    for (int j = 0; j < 4; ++j) { const f32x4 gt = *(const f32x4*)(gate + 4 * lane + 256 * j), gg = *(const f32x4*)(g + 4 * lane + 256 * j); h[j] = h[j] + gt * (y[j] * r * gg); }
}
__device__ __forceinline__ void norm_mod(const f32x4 (&h)[4], f32x4 (&o)[4], const float* g, const float* shift, const float* scale, int lane) {
    const float r = row_rstd(h);
#pragma unroll
    for (int j = 0; j < 4; ++j) { const f32x4 gg = *(const f32x4*)(g + 4 * lane + 256 * j), sh = *(const f32x4*)(shift + 4 * lane + 256 * j), sc = *(const f32x4*)(scale + 4 * lane + 256 * j);
        o[j] = (h[j] * r * gg) * (1.0f + sc) + sh; }
}

typedef unsigned short bf16;
#define XB_TMO      128
#define XB_XCNT(j)  (256  + 64 * (j))
#define XB_XSUB(j)  (1280 + 64 * (j))
#define XB_XGEN(j)  (2304 + 64 * (j))
#define XB_TOP      3328
#define XB_TOPGEN   3392
#define XCD_BAR_WORDS 3456
#define XB_SPIN_CAP (1u << 18)

__device__ __forceinline__ unsigned xb_ld(unsigned* p)              { return __hip_atomic_load(p, __ATOMIC_RELAXED, __HIP_MEMORY_SCOPE_AGENT); }
__device__ __forceinline__ unsigned xb_add(unsigned* p, unsigned v) { return __hip_atomic_fetch_add(p, v, __ATOMIC_RELAXED, __HIP_MEMORY_SCOPE_AGENT); }
__device__ __forceinline__ unsigned xb_xcc_id() { return (unsigned)__builtin_amdgcn_s_getreg((3 << 11) | 20) & 0xFu; }
#define XB_SPIN(cond, bar) do { unsigned _sp = 0; while (cond) { __builtin_amdgcn_s_sleep(1); \
    if ((++_sp & 255u) == 0u) { if (xb_ld(&(bar)[XB_TMO])) break; if (_sp > XB_SPIN_CAP) { atomicAdd(&(bar)[XB_TMO], 1u); break; } } } } while (0)

struct XcdBarrier {
    unsigned* bar; unsigned x;
    volatile LAS unsigned* st;
};

__device__ __forceinline__ XcdBarrier xcd_barrier_post(unsigned* bar, volatile LAS unsigned* st) {
    XcdBarrier b; b.bar = bar; b.x = xb_xcc_id(); b.st = st;
    if (threadIdx.x == 0) (void)xb_add(&bar[XB_XCNT(b.x)], 1u);
    return b;
}
__device__ __forceinline__ void xcd_barrier_complete(unsigned* bar, unsigned x, unsigned& nloc, unsigned& nx) {
    const unsigned G = gridDim.x * gridDim.y * gridDim.z;
    unsigned sum, cnt, mine, sp = 0u;
    for (;;) {
        sum = 0u; cnt = 0u; mine = 0u;
#pragma unroll
        for (unsigned j = 0; j < 16; ++j) { const unsigned c = xb_ld(&bar[XB_XCNT(j)]); sum += c; cnt += (c > 0u) ? 1u : 0u; mine = (j == x) ? c : mine; }
        if (sum == G) break;
        __builtin_amdgcn_s_sleep(1);
        if ((++sp & 255u) == 0u) { if (xb_ld(&bar[XB_TMO])) break; if (sp > XB_SPIN_CAP) { atomicAdd(&bar[XB_TMO], 1u); break; } }
    }
    nloc = mine > 0u ? mine : 1u; nx = cnt > 0u ? cnt : 1u;
}

__device__ __forceinline__ void xcd_barrier(const XcdBarrier& b) {
    asm volatile("s_waitcnt vmcnt(0)" ::: "memory");
    __syncthreads();
    if (threadIdx.x == 0) {
        unsigned* bar = b.bar;
        __builtin_amdgcn_s_waitcnt(0);
        unsigned nloc = b.st[0], nx = b.st[1];
        if (nloc == 0u) { xcd_barrier_complete(bar, b.x, nloc, nx); b.st[0] = nloc; b.st[1] = nx; }
        const unsigned old = xb_add(&bar[XB_XSUB(b.x)], 1u);
        const unsigned gen = old / nloc;
        if (old + 1u == (gen + 1u) * nloc) {
            __builtin_amdgcn_fence(__ATOMIC_RELEASE, "agent");
            asm volatile("s_waitcnt vmcnt(0)" ::: "memory");
            const unsigned og = xb_add(&bar[XB_TOP], 1u);
            const unsigned tg = og / nx;
            if (og + 1u == (tg + 1u) * nx) xb_add(&bar[XB_TOPGEN], 1u);
            else XB_SPIN(xb_ld(&bar[XB_TOPGEN]) == tg, bar);
            __builtin_amdgcn_fence(__ATOMIC_ACQUIRE, "agent");
            xb_add(&bar[XB_XGEN(b.x)], 1u);
            asm volatile("s_waitcnt vmcnt(0)" ::: "memory");
        } else {
            XB_SPIN(xb_ld(&bar[XB_XGEN(b.x)]) == gen, bar);
            __builtin_amdgcn_fence(__ATOMIC_ACQUIRE, "agent");
            asm volatile("s_waitcnt vmcnt(0)" ::: "memory");
        }
    }
    __syncthreads();
}


#define GRID_SYNC() xcd_barrier(xbar)
__global__ void __launch_bounds__(NTHREADS) fwd_megakernel(Args a) {
    extern __shared__ __attribute__((aligned(16))) unsigned char lds[];
    cg::grid_group grid = cg::this_grid();
    LAS unsigned char* ldsl = (LAS unsigned char*)lds;
    const int tid = threadIdx.x, lane = tid & 63, wave = __builtin_amdgcn_readfirstlane(tid >> 6);
    const int G = gridDim.x, bx = blockIdx.x;
    volatile LAS unsigned* MISC = (volatile LAS unsigned*)(ldsl + LDS_BYTES - 64);
    if (tid < 16) MISC[tid] = 0u;
    __syncthreads();
    XcdBarrier xbar = xcd_barrier_post((unsigned*)a.ws, MISC + 8);
    const int vcu = (G % 8 == 0) ? (bx % 8) * (G / 8) + bx / 8 : bx;
    const int gw = vcu * NWAVES + wave, NGW = G * NWAVES;
    const int xrow0 = (bx & 7) * 2048 + (bx >> 3) * NWAVES + wave, xrow1 = (bx & 7) * 2048 + 2048;
    unsigned char* ws = a.ws;
    float* mods = (float*)(ws + WS_MODS);
    f32x2* rope = (f32x2*)(ws + WS_ROPE);
    bf16_t* WGU1 = (bf16_t*)(ws + WS_WGU1); bf16_t* WD1 = (bf16_t*)(ws + WS_WD1); bf16_t* WGU2 = (bf16_t*)(ws + WS_WGU2); bf16_t* WD2 = (bf16_t*)(ws + WS_WD2);
    bf16_t* WIN = (bf16_t*)(ws + WS_WIN); bf16_t* WPA = (bf16_t*)(ws + WS_WPA); bf16_t* WPB = (bf16_t*)(ws + WS_WPB); bf16_t* WOUT = (bf16_t*)(ws + WS_WOUT);
    bf16_t* Y1 = (bf16_t*)(ws + WS_Y1); bf16_t* R1 = (bf16_t*)(ws + WS_R1); bf16_t* HID = (bf16_t*)(ws + WS_HID);
    bf16_t* Qb = (bf16_t*)(ws + WS_Q); bf16_t* Kb = (bf16_t*)(ws + WS_K); bf16_t* Vb = (bf16_t*)(ws + WS_V); bf16_t* Ob = (bf16_t*)(ws + WS_O);
    bf16_t* BG = (bf16_t*)(ws + WS_BG); bf16_t* Zb = (bf16_t*)(ws + WS_Z); bf16_t* GA = (bf16_t*)(ws + WS_GA); bf16_t* GB = (bf16_t*)a.out;
    bf16_t* Y2 = Zb; bf16_t* Y3 = (bf16_t*)(ws + WS_Y3);

    {
        LAS float* sil = (LAS float*)ldsl;
        LAS float* red = (LAS float*)(ldsl + 12288);
        for (int idx = tid; idx < 3072; idx += NTHREADS) { const int v = idx >> 10, k = idx & 1023; const float cv = (v < 2) ? a.c[v * DM + k] : a.c_ctx[k]; sil[idx] = cv * fast_sigmoid(cv); }
        __syncthreads();
        const bool act = lane < 36; const int j = bx * 36 + (act ? lane : 0), kb = wave * 128;
        float s0 = 0.f, s1 = 0.f, s2 = 0.f;
        if (act) {
#pragma unroll 8
        for (int kk = 0; kk < 128; ++kk) { const float w = __builtin_nontemporal_load(a.w_mod + (size_t)(kb + kk) * NMOD + j); s0 += sil[kb + kk] * w; s1 += sil[1024 + kb + kk] * w; s2 += sil[2048 + kb + kk] * w; }
        }
        red[(wave * 3 + 0) * 64 + lane] = s0; red[(wave * 3 + 1) * 64 + lane] = s1; red[(wave * 3 + 2) * 64 + lane] = s2;
        __syncthreads();
        if (wave < 3 && act) { float s = a.b_mod[j];
#pragma unroll
            for (int w = 0; w < 8; ++w) s += red[(w * 3 + wave) * 64 + lane];
            mods[wave * NMOD + j] = s; }
        __syncthreads();
    }
    if (bx == 144) {
        for (int idx = tid; idx < 128 * 16; idx += NTHREADS) { const int pos = idx >> 4, f = idx & 15;
            const float inv = powf(10000.0f, -(float)f / 16.0f); const float ang = (float)pos * inv;
            rope[idx] = (f32x2){cosf(ang), sinf(ang)}; }
    }
    {
        LAS float* scr = (LAS float*)(ldsl + 16384 + wave * 12288);
        constexpr int I_GU = (DM / 64) * (FF / 32), I_D = (FF / 64) * (DM / 32), I_IN = (DM / 64) * (INW / 32), I_SQ = (DM / 64) * (DM / 32);
        constexpr int NITEMS = 4 * I_GU + 2 * I_D + I_IN + 3 * I_SQ;
        for (int it = gw; it < NITEMS; it += NGW) {
            int r = it;
            if (r < I_GU) { transpose_item<1>(a.f1_wg, DM, FF, WGU1, scr, r, lane); continue; } r -= I_GU;
            if (r < I_GU) { transpose_item<2>(a.f1_wu, DM, FF, WGU1, scr, r, lane); continue; } r -= I_GU;
            if (r < I_D)  { transpose_item<0>(a.f1_wd, FF, DM, WD1, scr, r, lane); continue; } r -= I_D;
            if (r < I_IN) { transpose_item<3>(a.w_in, DM, INW, WIN, scr, r, lane); continue; } r -= I_IN;
            if (r < I_SQ) { transpose_item<0>(a.w_pa, DM, DM, WPA, scr, r, lane); continue; } r -= I_SQ;
            if (r < I_SQ) { transpose_item<0>(a.w_pb, DM, DM, WPB, scr, r, lane); continue; } r -= I_SQ;
            if (r < I_SQ) { transpose_item<0>(a.w_out, DM, DM, WOUT, scr, r, lane); continue; } r -= I_SQ;
            if (r < I_GU) { transpose_item<1>(a.f2_wg, DM, FF, WGU2, scr, r, lane); continue; } r -= I_GU;
            if (r < I_GU) { transpose_item<2>(a.f2_wu, DM, FF, WGU2, scr, r, lane); continue; } r -= I_GU;
            transpose_item<0>(a.f2_wd, FF, DM, WD2, scr, r, lane);
        }
    }
    GRID_SYNC();
    if (__builtin_expect(a.ws == nullptr, 0)) grid.sync();

    for (int trip = 0; trip < 9; ++trip) { const int row = trip < 8 ? xrow0 + 256 * trip : ML + gw; if (row >= MT) break;
        const float* src = row < ML ? a.x + (size_t)row * DM : a.ctx + (size_t)(row - ML) * DM;
        const float* md = mods + (row < ML ? (row >> 13) : 2) * NMOD;
        f32x4 h[4], o[4]; load_row_f32(src, lane, h);
        norm_mod(h, o, a.f1_pre, md + 0 * DM, md + 1 * DM, lane);
        store_row_bf16(R1 + (size_t)row * DM, lane, o);
    }
    GRID_SYNC();

    unsigned* ctxctr = (unsigned*)(ws + 32768);
    { pg8::Gemm g{R1, WGU1, MT, 2 * FF, DM}; pg8::CtxGUOrder S{bx}; pg8::EpiSwiGLU E{HID, FF};
      pg8::gemm_phase(ldsl, g, S, E);
      if (bx >= 8 && bx < 52) { asm volatile("s_waitcnt vmcnt(0)" ::: "memory"); __syncthreads();
        if (tid == 0) { __builtin_amdgcn_fence(__ATOMIC_RELEASE, "agent"); asm volatile("s_waitcnt vmcnt(0)" ::: "memory");
                        __hip_atomic_fetch_add(ctxctr, 1u, __ATOMIC_RELAXED, __HIP_MEMORY_SCOPE_AGENT); } } }
    { pg8::Gemm g{R1, WGU1, ML, 2 * FF, DM}; pg8::LatGUOrder S; S.S.init(ML, 2 * FF, G, bx); S.c = bx; pg8::EpiSwiGLU E{HID, FF};
      pg8::gemm_phase(ldsl, g, S, E); }
    if (bx < 8) {
        if (tid == 0) { while (__hip_atomic_load(ctxctr, __ATOMIC_RELAXED, __HIP_MEMORY_SCOPE_AGENT) < 44u) __builtin_amdgcn_s_sleep(8); }
        __syncthreads(); __builtin_amdgcn_fence(__ATOMIC_ACQUIRE, "agent"); asm volatile("s_waitcnt vmcnt(0)" ::: "memory");
        pg8::Gemm g{HID, WD1, MT, DM, FF}; pg8::CtxDownOrder S{bx}; pg8::EpiPlain E{Y1, DM};
        pg8::gemm_phase(ldsl, g, S, E); }
    GRID_SYNC();
    if (wave < 2) {
        const int row = ML + bx * 2 + wave; const float* md = mods + 2 * NMOD;
        f32x4 h[4], y[4], o[4]; load_row_f32(a.ctx + (size_t)(row - ML) * DM, lane, h); load_row_bf16(Y1 + (size_t)row * DM, lane, y);
        add_branch(h, y, 0.5f, md + 2 * DM, a.f1_post, lane);
        norm_mod(h, o, a.mix_pre, md + 3 * DM, md + 4 * DM, lane);
        store_row_bf16(R1 + (size_t)row * DM, lane, o);
    }
    { pg8::Gemm g{HID, WD1, ML, DM, FF}; pg8::StaticOrder S; S.init(ML, DM, G, bx); pg8::EpiPlain E{Y1, DM};
      pg8::gemm_phase(ldsl, g, S, E); }
    GRID_SYNC();

    if (bx < 16) {
        pg8::Gemm g{R1, WIN, MT, 3072, DM}; pg8::CtxKVOrder S{bx}; pg8::EpiQKV E{Qb, Kb, Vb, rope};
        pg8::gemm_phase(ldsl, g, S, E);
    } else {
        for (int rl = ((bx >> 3) - 2) * NWAVES + wave; rl < 2048; rl += 30 * NWAVES) { const int row = (bx & 7) * 2048 + rl;
            const float* md = mods + (row >> 13) * NMOD;
            f32x4 h[4], y[4], o[4]; load_row_f32(a.x + (size_t)row * DM, lane, h); load_row_bf16(Y1 + (size_t)row * DM, lane, y);
            add_branch(h, y, 0.5f, md + 2 * DM, a.f1_post, lane);
            norm_mod(h, o, a.mix_pre, md + 3 * DM, md + 4 * DM, lane);
            store_row_bf16(R1 + (size_t)row * DM, lane, o);
        }
    }
    GRID_SYNC();

    { pg8::Gemm g{R1, WIN, ML, 3072, DM}; pg8::StaticOrder S; S.init(ML, 3072, G, bx); pg8::EpiQKV E{Qb, Kb, Vb, rope};
      pg8::gemm_phase(ldsl, g, S, E); }
    GRID_SYNC();

    {
        float d1 = 0.f, d2 = 0.f;
        for (int i = 0; i < 64; ++i) { d1 += a.lq1[i] * a.lk1[i]; d2 += a.lq2[i] * a.lk2[i]; }
        const float lam = expf(d1) - expf(d2) + LAM_INIT;
        for (int u = vcu; u < NB * 8 * (SEQ / 256); u += G) {
            const int bh = u >> 5, qb = u & 31;
            att::attn_unit(bh >> 3, bh & 7, qb, Qb, Kb, Vb, Ob, (bf16_t*)a.out, a.subln, lam, (char*)lds);
        }
    }
    GRID_SYNC();

    { pg8::Gemm g{R1, WIN + (size_t)3072 * DM, ML, 5120, DM}; pg8::StaticOrder S; S.init(ML, 5120, G, bx); pg8::EpiRest E{BG, Zb, GA, GB};
      pg8::gemm_phase(ldsl, g, S, E); }
    GRID_SYNC();

    for (int row = xrow0; row < xrow1; row += 256) {
        const int t = row & (SEQ - 1);
#pragma unroll
        for (int j = 0; j < 2; ++j) { const int col = 8 * lane + 512 * j;
            const u32x4 zc = *(const u32x4*)(Zb + (size_t)row * DM + col);
            u32x4 zp = (u32x4){0, 0, 0, 0}, zn = (u32x4){0, 0, 0, 0};
            if (t > 0) zp = *(const u32x4*)(Zb + (size_t)(row - 1) * DM + col);
            if (t < SEQ - 1) zn = *(const u32x4*)(Zb + (size_t)(row + 1) * DM + col);
            const u32x4 bg = __builtin_nontemporal_load((const u32x4*)(BG + (size_t)row * DM + col));
            const f32x4 w0a = *(const f32x4*)(a.conv_w + col), w0b = *(const f32x4*)(a.conv_w + col + 4);
            const f32x4 w1a = *(const f32x4*)(a.conv_w + DM + col), w1b = *(const f32x4*)(a.conv_w + DM + col + 4);
            const f32x4 w2a = *(const f32x4*)(a.conv_w + 2 * DM + col), w2b = *(const f32x4*)(a.conv_w + 2 * DM + col + 4);
            f32x4 ra, rb;
            ra[0] = bf_lo(bg.x) * (w0a[0] * bf_lo(zp.x) + w1a[0] * bf_lo(zc.x) + w2a[0] * bf_lo(zn.x));
            ra[1] = bf_hi(bg.x) * (w0a[1] * bf_hi(zp.x) + w1a[1] * bf_hi(zc.x) + w2a[1] * bf_hi(zn.x));
            ra[2] = bf_lo(bg.y) * (w0a[2] * bf_lo(zp.y) + w1a[2] * bf_lo(zc.y) + w2a[2] * bf_lo(zn.y));
            ra[3] = bf_hi(bg.y) * (w0a[3] * bf_hi(zp.y) + w1a[3] * bf_hi(zc.y) + w2a[3] * bf_hi(zn.y));
            rb[0] = bf_lo(bg.z) * (w0b[0] * bf_lo(zp.z) + w1b[0] * bf_lo(zc.z) + w2b[0] * bf_lo(zn.z));
            rb[1] = bf_hi(bg.z) * (w0b[1] * bf_hi(zp.z) + w1b[1] * bf_hi(zc.z) + w2b[1] * bf_hi(zn.z));
            rb[2] = bf_lo(bg.w) * (w0b[2] * bf_lo(zp.w) + w1b[2] * bf_lo(zc.w) + w2b[2] * bf_lo(zn.w));
            rb[3] = bf_hi(bg.w) * (w0b[3] * bf_hi(zp.w) + w1b[3] * bf_hi(zc.w) + w2b[3] * bf_hi(zn.w));
            *(u32x4*)(BG + (size_t)row * DM + col) = pg8::pack8(ra, rb); }
    }
    GRID_SYNC();

    { pg8::Gemm g{Ob, WPA, ML, DM, DM}; pg8::StaticOrder S; S.init(ML, DM, G, bx); pg8::EpiGate<0> E{GA, GB};
      pg8::gemm_phase(ldsl, g, S, E); }
    { pg8::Gemm g{BG, WPB, ML, DM, DM}; pg8::StaticOrder S; S.init(ML, DM, G, bx); pg8::EpiGate<1> E{GA, GB};
      pg8::gemm_phase(ldsl, g, S, E); }
    GRID_SYNC();
    { pg8::Gemm g{GB, WOUT, ML, DM, DM}; pg8::StaticOrder S; S.init(ML, DM, G, bx); pg8::EpiPlain E{Y2, DM};
      pg8::gemm_phase(ldsl, g, S, E); }
    GRID_SYNC();

    for (int row = xrow0; row < xrow1; row += 256) {
        const float* md = mods + (row >> 13) * NMOD;
        f32x4 h[4], y[4], o[4]; load_row_f32(a.x + (size_t)row * DM, lane, h); load_row_bf16(Y1 + (size_t)row * DM, lane, y);
        add_branch(h, y, 0.5f, md + 2 * DM, a.f1_post, lane);
        load_row_bf16(Y2 + (size_t)row * DM, lane, y);
        add_branch(h, y, 1.0f, md + 5 * DM, a.mix_post, lane);
        store_row_f32(a.out + (size_t)row * DM, lane, h);
        norm_mod(h, o, a.f2_pre, md + 6 * DM, md + 7 * DM, lane);
        store_row_bf16(R1 + (size_t)row * DM, lane, o);
    }
    GRID_SYNC();

    { pg8::Gemm g{R1, WGU2, ML, 2 * FF, DM}; pg8::StaticOrder S; S.init(ML, 2 * FF, G, bx); pg8::EpiSwiGLU E{HID, FF};
      pg8::gemm_phase(ldsl, g, S, E); }
    GRID_SYNC();
    { pg8::Gemm g{HID, WD2, ML, DM, FF}; pg8::StaticOrder S; S.init(ML, DM, G, bx); pg8::EpiPlain E{Y3, DM};
      pg8::gemm_phase(ldsl, g, S, E); }
    GRID_SYNC();

    for (int row = xrow0; row < xrow1; row += 256) {
        const float* md = mods + (row >> 13) * NMOD;
        f32x4 h[4], y[4]; load_row_f32(a.out + (size_t)row * DM, lane, h); load_row_bf16(Y3 + (size_t)row * DM, lane, y);
        add_branch(h, y, 0.5f, md + 8 * DM, a.f2_post, lane);
        store_row_f32(a.out + (size_t)row * DM, lane, h);
    }
}

extern "C" void kernel_launch(void* const* d_in, const int* in_sizes, int n_in, void* d_out, int out_size, void* d_ws, size_t ws_size, hipStream_t stream) {
    static int grid = 0;
    if (grid == 0) {
        int dev = 0, cus = 0, per_cu = 0;
        hipGetDevice(&dev);
        hipDeviceGetAttribute(&cus, hipDeviceAttributeMultiprocessorCount, dev);
        if (hipFuncSetAttribute((const void*)fwd_megakernel, hipFuncAttributeMaxDynamicSharedMemorySize, LDS_BYTES) != hipSuccess) { fprintf(stderr, "hipFuncSetAttribute failed\n"); }
        hipOccupancyMaxActiveBlocksPerMultiprocessor(&per_cu, (const void*)fwd_megakernel, NTHREADS, LDS_BYTES);
        (void)hipGetLastError();
        if (per_cu < 1) { fprintf(stderr, "occupancy query says %d blocks/CU\n", per_cu); per_cu = 1; }
        grid = cus;
        if (n_in != 28 || ws_size < 256 * MiB) fprintf(stderr, "unexpected n_in %d / ws %zu\n", n_in, ws_size);
    }
    (void)hipMemsetAsync(d_ws, 0, 49152, stream);
    Args a{};
    const float** p = (const float**)&a;
    for (int i = 0; i < 28; ++i) p[i] = (const float*)d_in[i];
    a.out = (float*)d_out; a.ws = (unsigned char*)d_ws;
    void* args[] = {&a};
    hipError_t e = hipLaunchCooperativeKernel((const void*)fwd_megakernel, dim3(grid), dim3(NTHREADS), args, LDS_BYTES, stream);
    if (e != hipSuccess) fprintf(stderr, "cooperative launch failed: %s (grid %d)\n", hipGetErrorString(e), grid);
}
```

```cpp
#include <hip/hip_runtime.h>
#include <hip/hip_cooperative_groups.h>
#include <cstdio>
#include <cstdint>
namespace cg = cooperative_groups;

#define LAS __attribute__((address_space(3)))
typedef unsigned short bf16_t;
typedef short bf16x8 __attribute__((ext_vector_type(8)));
typedef short s16x4 __attribute__((ext_vector_type(4)));
typedef float f32x4 __attribute__((ext_vector_type(4)));
typedef float f32x2 __attribute__((ext_vector_type(2)));
typedef float f32x16 __attribute__((ext_vector_type(16)));
typedef unsigned u32x4 __attribute__((ext_vector_type(4)));
typedef unsigned u32x2 __attribute__((ext_vector_type(2)));

constexpr int DM = 1024, SEQ = 8192, NB = 2, CTXL = 256, FF = 2816, INW = 8192;
constexpr int ML = NB * SEQ;
constexpr int MC = NB * CTXL;
constexpr int MT = ML + MC;
constexpr int NKV = SEQ + CTXL;
constexpr int NMOD = 9 * DM;
constexpr float EPS = 1e-6f;
constexpr float LAM_INIT = 0.2f;

constexpr size_t MiB = 1u << 20;
constexpr size_t WS_MODS = 64 * 1024;
constexpr size_t WS_ROPE = 256 * 1024;
constexpr size_t WS_WGU1 = 1 * MiB;
constexpr size_t WS_WD1  = 12 * MiB;
constexpr size_t WS_WGU2 = 18 * MiB;
constexpr size_t WS_WD2  = 29 * MiB;
constexpr size_t WS_WIN  = 35 * MiB;
constexpr size_t WS_WPA  = 51 * MiB, WS_WPB = 53 * MiB, WS_WOUT = 55 * MiB;
constexpr size_t WS_Y1   = 57 * MiB;
constexpr size_t WS_R1   = 90 * MiB;
constexpr size_t WS_R2   = 123 * MiB;
constexpr size_t WS_HID  = WS_R2;
constexpr size_t WS_Q    = WS_R2;
constexpr size_t WS_K    = WS_R2 + 32 * MiB;
constexpr size_t WS_V    = WS_R2 + 65 * MiB;
constexpr size_t WS_O    = WS_R2 + 99 * MiB;
constexpr size_t WS_BG   = WS_R2;
constexpr size_t WS_Z    = WS_R2 + 32 * MiB;
constexpr size_t WS_GA   = WS_R2 + 64 * MiB;
constexpr size_t WS_Y3   = WS_R2 + 96 * MiB;
static_assert(WS_O + 32 * MiB <= 256 * MiB, "ws map");

typedef __bf16 bf16x2_t __attribute__((ext_vector_type(2)));
__device__ __forceinline__ unsigned cvt_pk_bf16(float lo, float hi) { f32x2 v = {lo, hi}; bf16x2_t b = __builtin_convertvector(v, bf16x2_t); return __builtin_bit_cast(unsigned, b); }
__device__ __forceinline__ float bf_lo(unsigned w) { return __uint_as_float(w << 16); }
__device__ __forceinline__ float bf_hi(unsigned w) { return __uint_as_float(w & 0xffff0000u); }
__device__ __forceinline__ float fast_sigmoid(float x) { return __builtin_amdgcn_rcpf(1.0f + __builtin_amdgcn_exp2f(-1.4426950408889634f * x)); }

namespace pg8 {
constexpr int BM = 256, BK = 64, HALF = 128, HTB = HALF * BK * 2, STAGE_BYTES = 8 * HTB, NXCD = 8, WGM = 8;
__host__ __device__ __forceinline__ int lds_byte(int r, int c) { const int st = (r >> 4) * 2 + (c >> 5), rr = r & 15, cc = c & 31, ob = rr * 64 + cc * 2; return st * 1024 + (ob ^ (((ob >> 9) & 1) << 5)); }
__host__ __device__ __forceinline__ void stage_rc(int b, int& R, int& C) { const int st = b / 1024, sb = b % 1024, swz = sb ^ (((sb >> 9) & 1) << 5); R = (st >> 1) * 16 + swz / 64; C = (st & 1) * 32 + (swz % 64) / 2; }
__host__ __device__ __forceinline__ int perm32(int rho) { const int n = rho >> 4, i = rho & 15; return 8 * (i >> 2) + 4 * n + (i & 3); }

struct Unit { int pm, pn; };
struct Gemm { const bf16_t* A; const bf16_t* Bt; int M, N, K; };

struct StaticOrder {
    int nM, nN, nwg, G, c;
    __device__ void init(int M, int N, int G_, int c_) { nM = M / BM; nN = N / BM; nwg = nM * nN; G = G_; c = c_; }
    __device__ bool map(long L, Unit& u) const {
        if (L >= nwg) return false;
        int wgid = (int)L; { const int q = nwg / NXCD, r = nwg % NXCD, xcd = wgid % NXCD, off = wgid / NXCD; wgid = (xcd < r ? xcd * (q + 1) : r * (q + 1) + (xcd - r) * q) + off; }
        const int nig = WGM * nN, gid = wgid / nig, fm = gid * WGM, gsz = (nM - fm) < WGM ? (nM - fm) : WGM;
        u.pm = fm + ((wgid % nig) % gsz); u.pn = (wgid % nig) / gsz; return true;
    }
    __device__ bool next(int i, Unit& u) const { return map((long)i * G + c, u); }
};
struct CtxGUOrder  { int c; __device__ bool next(int i, Unit& u) const { if (i > 0 || c < 8 || c >= 52) return false; const int e = c - 8; u.pm = 64 + (e & 1); u.pn = e >> 1; return true; } };
struct CtxDownOrder { int c; __device__ bool next(int i, Unit& u) const { if (i > 0 || c >= 8) return false; u.pm = 64 + (c >> 2); u.pn = c & 3; return true; } };
struct CtxKVOrder  { int c; __device__ bool next(int i, Unit& u) const { if (i > 0 || c >= 16) return false; u.pm = 64 + (c >> 3); u.pn = 4 + (c & 7); return true; } };
struct LatGUOrder { StaticOrder S; int c;
    __device__ bool next(int i, Unit& u) const { long L;
        if (i < 3) L = (long)i * 256 + c; else if (i < 5) { if (c < 8) return false; L = 768 + (long)(i - 3) * 248 + (c - 8); } else if (i == 5) { if (c < 52) return false; L = 1264 + (c - 52); } else return false;
        return S.map(L, u); } };
typedef f32x4 Acc[2][2][4][2];

__device__ __forceinline__ u32x4 pack8(f32x4 a, f32x4 b) { u32x4 w; w.x = cvt_pk_bf16(a[0], a[1]); w.y = cvt_pk_bf16(a[2], a[3]); w.z = cvt_pk_bf16(b[0], b[1]); w.w = cvt_pk_bf16(b[2], b[3]); return w; }

struct EpiPlain {
    static constexpr bool PERM = true;
    bf16_t* O; int ldc;
    __device__ __forceinline__ void operator()(const Acc& acc, const Unit& u, int wr, int wc, int fr, int fq) const {
        const int row0 = u.pm * BM + wr * 64 + fr, col0 = u.pn * BM + wc * 32 + 8 * fq;
#pragma unroll
        for (int ai = 0; ai < 2; ++ai)
#pragma unroll
            for (int m = 0; m < 4; ++m) { bf16_t* rowp = O + (size_t)(row0 + ai * HALF + m * 16) * ldc + col0;
#pragma unroll
                for (int bj = 0; bj < 2; ++bj) *(u32x4*)(rowp + bj * HALF) = pack8(acc[ai][bj][m][0], acc[ai][bj][m][1]); }
    }
};
struct EpiSwiGLU {
    static constexpr bool PERM = true;
    bf16_t* O; int ldc;
    __device__ __forceinline__ void operator()(const Acc& acc, const Unit& u, int wr, int wc, int fr, int fq) const {
        const int row0 = u.pm * BM + wr * 64 + fr, col0 = u.pn * HALF + wc * 32 + 8 * fq;
#pragma unroll
        for (int ai = 0; ai < 2; ++ai)
#pragma unroll
            for (int m = 0; m < 4; ++m) { bf16_t* rowp = O + (size_t)(row0 + ai * HALF + m * 16) * ldc + col0;
                f32x4 h[2];
#pragma unroll
                for (int n = 0; n < 2; ++n)
#pragma unroll
                    for (int i = 0; i < 4; ++i) { const float g = acc[ai][0][m][n][i], up = acc[ai][1][m][n][i]; h[n][i] = g * fast_sigmoid(g) * up; }
                *(u32x4*)rowp = pack8(h[0], h[1]); }
    }
};
struct EpiQKV {
    static constexpr bool PERM = true;
    bf16_t *Q, *Kb, *Vb; const f32x2* rope;
    __device__ __forceinline__ void operator()(const Acc& acc, const Unit& u, int wr, int wc, int fr, int fq) const {
        const int pn = u.pn;
#pragma unroll
        for (int ai = 0; ai < 2; ++ai)
#pragma unroll
            for (int m = 0; m < 4; ++m) {
                const int row = u.pm * BM + ai * HALF + wr * 64 + m * 16 + fr;
                const bool ctx = row >= ML;
                int t, kvrow;
                if (!ctx) { const int b = row >> 13; t = row & (SEQ - 1); kvrow = b * NKV + CTXL + t; }
                else { const int rc = row - ML, b = rc >> 8; t = rc & (CTXL - 1); kvrow = b * NKV + t; }
                if (pn < 8) {
                    const int hh = wc >> 1, mm = wc & 1, axis = fq >> 1, f0 = 8 * (fq & 1);
                    const int col = (2 * (pn & 3) + hh) * 128 + mm * 64 + axis * 32 + f0;
                    f32x4 x0a = acc[ai][0][m][0], x0b = acc[ai][0][m][1], x1a = acc[ai][1][m][0], x1b = acc[ai][1][m][1];
                    if (pn < 4) { constexpr float QS = 0.125f * 1.4426950408889634f; x0a = x0a * QS; x0b = x0b * QS; x1a = x1a * QS; x1b = x1b * QS; }
                    if (!ctx) {
                        const int pos = axis ? (t & 63) : (t >> 6);
                        const f32x4* rp = (const f32x4*)(rope + pos * 16 + f0);
                        const f32x4 c01 = rp[0], c23 = rp[1], c45 = rp[2], c67 = rp[3];
                        f32x4 o0a, o0b, o1a, o1b;
                        o0a[0] = x0a[0] * c01[0] - x1a[0] * c01[1]; o1a[0] = x1a[0] * c01[0] + x0a[0] * c01[1];
                        o0a[1] = x0a[1] * c01[2] - x1a[1] * c01[3]; o1a[1] = x1a[1] * c01[2] + x0a[1] * c01[3];
                        o0a[2] = x0a[2] * c23[0] - x1a[2] * c23[1]; o1a[2] = x1a[2] * c23[0] + x0a[2] * c23[1];
                        o0a[3] = x0a[3] * c23[2] - x1a[3] * c23[3]; o1a[3] = x1a[3] * c23[2] + x0a[3] * c23[3];
                        o0b[0] = x0b[0] * c45[0] - x1b[0] * c45[1]; o1b[0] = x1b[0] * c45[0] + x0b[0] * c45[1];
                        o0b[1] = x0b[1] * c45[2] - x1b[1] * c45[3]; o1b[1] = x1b[1] * c45[2] + x0b[1] * c45[3];
                        o0b[2] = x0b[2] * c67[0] - x1b[2] * c67[1]; o1b[2] = x1b[2] * c67[0] + x0b[2] * c67[1];
                        o0b[3] = x0b[3] * c67[2] - x1b[3] * c67[3]; o1b[3] = x1b[3] * c67[2] + x0b[3] * c67[3];
                        x0a = o0a; x0b = o0b; x1a = o1a; x1b = o1b;
                    }
                    bf16_t* dst = (pn < 4) ? (Q + (size_t)row * DM) : (Kb + (size_t)kvrow * DM);
                    if (pn >= 4 || !ctx) { *(u32x4*)(dst + col) = pack8(x0a, x0b); *(u32x4*)(dst + col + 16) = pack8(x1a, x1b); }
                } else {
                    bf16_t* dst = Vb + (size_t)kvrow * DM + (pn - 8) * BM + wc * 32 + 8 * fq;
#pragma unroll
                    for (int bj = 0; bj < 2; ++bj) *(u32x4*)(dst + bj * HALF) = pack8(acc[ai][bj][m][0], acc[ai][bj][m][1]);
                }
            }
    }
};
struct EpiRest {
    static constexpr bool PERM = true;
    bf16_t *Bg, *Z, *GA, *GB;
    __device__ __forceinline__ void operator()(const Acc& acc, const Unit& u, int wr, int wc, int fr, int fq) const {
        const int pn = u.pn, row0 = u.pm * BM + wr * 64 + fr, cin = wc * 32 + 8 * fq;
#pragma unroll
        for (int ai = 0; ai < 2; ++ai)
#pragma unroll
            for (int m = 0; m < 4; ++m) { const size_t ro = (size_t)(row0 + ai * HALF + m * 16) * DM;
                if (pn >= 4 && pn < 12) {
                    *(u32x4*)(Z + ro + (pn - 4) * HALF + cin) = pack8(acc[ai][0][m][0] * acc[ai][1][m][0], acc[ai][0][m][1] * acc[ai][1][m][1]);
                } else if (pn < 4) {
#pragma unroll
                    for (int bj = 0; bj < 2; ++bj) *(u32x4*)(Bg + ro + pn * BM + bj * HALF + cin) = pack8(acc[ai][bj][m][0], acc[ai][bj][m][1]);
                } else {
                    bf16_t* G = (pn < 16) ? GA : GB; const int ct = (pn < 16) ? pn - 12 : pn - 16;
#pragma unroll
                    for (int bj = 0; bj < 2; ++bj) { f32x4 s[2];
#pragma unroll
                        for (int n = 0; n < 2; ++n)
#pragma unroll
                            for (int i = 0; i < 4; ++i) s[n][i] = fast_sigmoid(acc[ai][bj][m][n][i]);
                        *(u32x4*)(G + ro + ct * BM + bj * HALF + cin) = pack8(s[0], s[1]); }
                }
            }
    }
};
template <int MODE> struct EpiGate {
    static constexpr bool PERM = true;
    bf16_t *GA, *GB;
    __device__ __forceinline__ void operator()(const Acc& acc, const Unit& u, int wr, int wc, int fr, int fq) const {
        const int row0 = u.pm * BM + wr * 64 + fr, col0 = u.pn * BM + wc * 32 + 8 * fq;
#pragma unroll
        for (int ai = 0; ai < 2; ++ai)
#pragma unroll
            for (int m = 0; m < 4; ++m) { const size_t ro = (size_t)(row0 + ai * HALF + m * 16) * DM + col0;
#pragma unroll
                for (int bj = 0; bj < 2; ++bj) {
                    const u32x4 ga = *(const u32x4*)(GA + ro + bj * HALF);
                    const f32x4 a0 = acc[ai][bj][m][0], a1 = acc[ai][bj][m][1];
                    f32x4 r0, r1;
                    if (MODE == 0) {
                        r0[0] = bf_lo(ga.x) * a0[0]; r0[1] = bf_hi(ga.x) * a0[1]; r0[2] = bf_lo(ga.y) * a0[2]; r0[3] = bf_hi(ga.y) * a0[3];
                        r1[0] = bf_lo(ga.z) * a1[0]; r1[1] = bf_hi(ga.z) * a1[1]; r1[2] = bf_lo(ga.w) * a1[2]; r1[3] = bf_hi(ga.w) * a1[3];
                        *(u32x4*)(GA + ro + bj * HALF) = pack8(r0, r1);
                    } else {
                        const u32x4 gb = __builtin_nontemporal_load((const u32x4*)(GB + ro + bj * HALF));
                        r0[0] = bf_lo(ga.x) + bf_lo(gb.x) * a0[0]; r0[1] = bf_hi(ga.x) + bf_hi(gb.x) * a0[1]; r0[2] = bf_lo(ga.y) + bf_lo(gb.y) * a0[2]; r0[3] = bf_hi(ga.y) + bf_hi(gb.y) * a0[3];
                        r1[0] = bf_lo(ga.z) + bf_lo(gb.z) * a1[0]; r1[1] = bf_hi(ga.z) + bf_hi(gb.z) * a1[1]; r1[2] = bf_lo(ga.w) + bf_lo(gb.w) * a1[2]; r1[3] = bf_hi(ga.w) + bf_hi(gb.w) * a1[3];
                        *(u32x4*)(GB + ro + bj * HALF) = pack8(r0, r1);
                    }
                } }
    }
};

template <class Epi, class Sched, bool ALIGN_EPI = true, bool SP2 = true>
__device__ __forceinline__ void gemm_phase(LAS unsigned char* lds, const Gemm g, const Sched& S, const Epi& E) {
    int tid_ = threadIdx.x; asm volatile("" : "+v"(tid_));
    const int tid = tid_, wid = __builtin_amdgcn_readfirstlane(tid >> 6), lane = tid & 63, wr = wid >> 2, wc = wid & 3, fr = lane & 15, fq = lane >> 4;
    const int K = g.K, nt = K / BK;
    unsigned voffA[2], voffB[2];
#pragma unroll
    for (int i = 0; i < 2; ++i) { int R, C; stage_rc(tid * 16 + i * 8192, R, C); const int Rb = Epi::PERM ? ((R & ~31) + perm32(R & 31)) : R;
        voffA[i] = (unsigned)(R * K + C) * 2u; voffB[i] = (unsigned)(Rb * K + C) * 2u; }
    const size_t kstep = (size_t)(BK * 2);
    const size_t hstep = (size_t)HALF * K * 2;
    const size_t tstep = 2 * hstep;
    const unsigned ldsw = (unsigned)wid * 1024u;
    const int aoff = lds_byte(wr * 64 + fr, fq * 8), boff = lds_byte(wc * 32 + fr, fq * 8);
#define PG8_SA(b, h) (((b) * 2 + (h)) * HTB)
#define PG8_SB(b, h) ((4 + (b) * 2 + (h)) * HTB)
#define PG8_STAGE(bufoff, gbase, voff) do { _Pragma("unroll") for (int _i = 0; _i < 2; ++_i) \
        __builtin_amdgcn_global_load_lds((const unsigned*)((const char*)(gbase) + (voff)[_i]), (LAS unsigned*)(lds + (bufoff) + ldsw + _i * 8192), 16, 0, 0); } while (0)
#define PG8_LDA(dst, b, h) do { _Pragma("unroll") for (int m = 0; m < 4; ++m) _Pragma("unroll") for (int k = 0; k < 2; ++k) dst[m][k] = *(const LAS bf16x8*)(lds + PG8_SA(b, h) + aoff + m * 2048 + k * 1024); } while (0)
#define PG8_LDB(dst, b, h) do { _Pragma("unroll") for (int n = 0; n < 2; ++n) _Pragma("unroll") for (int k = 0; k < 2; ++k) dst[n][k] = *(const LAS bf16x8*)(lds + PG8_SB(b, h) + boff + n * 2048 + k * 1024); } while (0)
#define PG8_MMA(ai, bj, At, Bt) do { __builtin_amdgcn_s_setprio(1); _Pragma("unroll") for (int m = 0; m < 4; ++m) _Pragma("unroll") for (int n = 0; n < 2; ++n) _Pragma("unroll") for (int k = 0; k < 2; ++k) \
        acc[ai][bj][m][n] = __builtin_amdgcn_mfma_f32_16x16x32_bf16(Bt[n][k], At[m][k], acc[ai][bj][m][n], 0, 0, 0); __builtin_amdgcn_s_setprio(0); } while (0)
#define PG8_WAIT_V(n) asm volatile("s_waitcnt vmcnt(" #n ")" ::: "memory")
#define PG8_WAIT_L(n) asm volatile("s_waitcnt lgkmcnt(" #n ")" ::: "memory")
#define PG8_BAR __builtin_amdgcn_s_barrier()
#define PG8_SCHED __builtin_amdgcn_sched_barrier(0)
    Unit cur, nxt; int ui = 0;
    if (!S.next(0, cur)) return;
    f32x4 acc[2][2][4][2];
#pragma unroll
    for (int a = 0; a < 2; ++a)
#pragma unroll
        for (int b = 0; b < 2; ++b)
#pragma unroll
            for (int m = 0; m < 4; ++m)
#pragma unroll
                for (int n = 0; n < 2; ++n) acc[a][b][m][n] = (f32x4){0.f, 0.f, 0.f, 0.f};
    bf16x8 At[4][2], B0[2][2], B1[2][2];
    const char* cA = (const char*)g.A + (size_t)cur.pm * tstep; const char* cB = (const char*)g.Bt + (size_t)cur.pn * tstep;
    if constexpr (SP2) {
        PG8_STAGE(PG8_SB(0, 0), cB, voffB); PG8_STAGE(PG8_SB(0, 1), cB + hstep, voffB); PG8_STAGE(PG8_SA(0, 0), cA, voffA); PG8_STAGE(PG8_SA(0, 1), cA + hstep, voffA);
        if (wr == 1) PG8_BAR;
        PG8_WAIT_V(2); PG8_BAR;
        PG8_STAGE(PG8_SB(1, 0), cB + kstep, voffB); PG8_STAGE(PG8_SA(1, 0), cA + kstep, voffA); PG8_STAGE(PG8_SB(1, 1), cB + hstep + kstep, voffB);
        PG8_WAIT_V(6); PG8_BAR;
    } else {
        PG8_STAGE(PG8_SB(0, 0), cB, voffB); PG8_STAGE(PG8_SA(0, 0), cA, voffA); PG8_STAGE(PG8_SB(0, 1), cB + hstep, voffB); PG8_STAGE(PG8_SA(0, 1), cA + hstep, voffA);
        if (wr == 1) PG8_BAR;
        PG8_WAIT_V(4); PG8_BAR;
        PG8_STAGE(PG8_SB(1, 0), cB + kstep, voffB); PG8_STAGE(PG8_SA(1, 0), cA + kstep, voffA); PG8_STAGE(PG8_SB(1, 1), cB + hstep + kstep, voffB);
        PG8_WAIT_V(6); PG8_BAR;
    }
    for (;;) {
        const bool has_next = S.next(ui + 1, nxt);
        const char* nA = has_next ? (const char*)g.A + (size_t)nxt.pm * tstep : cA; const char* nB = has_next ? (const char*)g.Bt + (size_t)nxt.pn * tstep : cB;
        for (int t = 0; t < nt; t += 2) {
            const bool last = (t == nt - 2);
            const char* a1 = cA + (size_t)(t + 1) * kstep;
            const char* a2 = last ? nA : cA + (size_t)(t + 2) * kstep; const char* b2 = last ? nB : cB + (size_t)(t + 2) * kstep;
            const char* a3 = a2 + kstep; const char* b3 = b2 + kstep;
            if constexpr (SP2) {
            PG8_LDB(B0, 0, 0); PG8_LDB(B1, 0, 1); PG8_SCHED; PG8_LDA(At, 0, 0); PG8_STAGE(PG8_SA(1, 1), a1 + hstep, voffA);
            PG8_WAIT_V(8); PG8_WAIT_L(0); PG8_BAR; PG8_MMA(0, 0, At, B0); PG8_MMA(0, 1, At, B1); PG8_BAR; PG8_SCHED;
            PG8_LDA(At, 0, 1); PG8_STAGE(PG8_SB(0, 0), b2, voffB); PG8_STAGE(PG8_SB(0, 1), b2 + hstep, voffB); PG8_STAGE(PG8_SA(0, 0), a2, voffA);
            PG8_WAIT_V(8); PG8_WAIT_L(0); PG8_BAR; PG8_MMA(1, 0, At, B0); PG8_MMA(1, 1, At, B1); PG8_BAR; PG8_SCHED;
            PG8_LDB(B0, 1, 0); PG8_LDB(B1, 1, 1); PG8_SCHED; PG8_LDA(At, 1, 0); PG8_STAGE(PG8_SA(0, 1), a2 + hstep, voffA);
            PG8_WAIT_V(8); PG8_WAIT_L(0); PG8_BAR; PG8_MMA(0, 0, At, B0); PG8_MMA(0, 1, At, B1); PG8_BAR; PG8_SCHED;
            PG8_LDA(At, 1, 1); PG8_STAGE(PG8_SB(1, 0), b3, voffB); PG8_STAGE(PG8_SB(1, 1), b3 + hstep, voffB); PG8_STAGE(PG8_SA(1, 0), a3, voffA);
            PG8_WAIT_V(8); PG8_WAIT_L(0); PG8_BAR; PG8_MMA(1, 0, At, B0); PG8_MMA(1, 1, At, B1); PG8_BAR; PG8_SCHED;
            } else {
            PG8_LDB(B0, 0, 0); PG8_SCHED; PG8_LDA(At, 0, 0); PG8_STAGE(PG8_SA(1, 1), a1 + hstep, voffA);
            PG8_WAIT_L(8); PG8_BAR; PG8_WAIT_L(0); PG8_MMA(0, 0, At, B0); PG8_BAR; PG8_SCHED;
            PG8_LDB(B1, 0, 1); PG8_STAGE(PG8_SB(0, 0), b2, voffB);
            PG8_BAR; PG8_WAIT_L(0); PG8_MMA(0, 1, At, B1); PG8_BAR;
            PG8_LDA(At, 0, 1); PG8_STAGE(PG8_SA(0, 0), a2, voffA);
            PG8_BAR; PG8_WAIT_L(0); PG8_MMA(1, 0, At, B0); PG8_BAR; PG8_SCHED;
            PG8_STAGE(PG8_SB(0, 1), b2 + hstep, voffB);
            PG8_WAIT_V(6); PG8_BAR; PG8_MMA(1, 1, At, B1); PG8_BAR;
            PG8_LDB(B0, 1, 0); PG8_SCHED; PG8_LDA(At, 1, 0); PG8_STAGE(PG8_SA(0, 1), a2 + hstep, voffA);
            PG8_WAIT_L(8); PG8_BAR; PG8_WAIT_L(0); PG8_MMA(0, 0, At, B0); PG8_BAR; PG8_SCHED;
            PG8_LDB(B1, 1, 1); PG8_STAGE(PG8_SB(1, 0), b3, voffB);
            PG8_BAR; PG8_WAIT_L(0); PG8_MMA(0, 1, At, B1); PG8_BAR;
            PG8_LDA(At, 1, 1); PG8_STAGE(PG8_SA(1, 0), a3, voffA);
            PG8_BAR; PG8_WAIT_L(0); PG8_MMA(1, 0, At, B0); PG8_BAR; PG8_SCHED;
            PG8_STAGE(PG8_SB(1, 1), b3 + hstep, voffB);
            PG8_WAIT_V(6); PG8_BAR; PG8_MMA(1, 1, At, B1); PG8_BAR;
            }
        }
        if constexpr (ALIGN_EPI) { if (wr == 0) PG8_BAR; }
        E(acc, cur, wr, wc, fr, fq);
        if (!has_next) break;
#pragma unroll
        for (int a = 0; a < 2; ++a)
#pragma unroll
            for (int b = 0; b < 2; ++b)
#pragma unroll
                for (int m = 0; m < 4; ++m)
#pragma unroll
                    for (int n = 0; n < 2; ++n) acc[a][b][m][n] = (f32x4){0.f, 0.f, 0.f, 0.f};
        cur = nxt; cA = nA; cB = nB; ++ui;
        if constexpr (ALIGN_EPI) { if (wr == 1) PG8_BAR; }
    }
    PG8_WAIT_V(0);
    if constexpr (!ALIGN_EPI) { if (wr == 0) PG8_BAR; }
    PG8_BAR;
#undef PG8_SA
#undef PG8_SB
#undef PG8_STAGE
#undef PG8_LDA
#undef PG8_LDB
#undef PG8_MMA
#undef PG8_WAIT_V
#undef PG8_WAIT_L
#undef PG8_BAR
#undef PG8_SCHED
}
}

namespace att {
constexpr int NW = 8, QBLK = 32, KVBLK = 64, LD = 1024, NT = NKV / KVBLK;
constexpr int SHM_V = KVBLK * 128 * 2, SHM_K = KVBLK * 64 * 2;
constexpr int NSLOT = 3, OFF_V = 0, OFF_K = NSLOT * SHM_V, OFF_WS = OFF_K + NSLOT * SHM_K, OFF_ST = OFF_WS + NW * 64 * 4, LDS_BYTES = OFF_ST + NW * 32 * 64 * 4;
constexpr float SCALE = 0.125f, THR = 8.f;
#define SBAR() __builtin_amdgcn_sched_barrier(0)
__device__ __forceinline__ int crow(int r, int hi) { return (r & 3) + 8 * (r >> 2) + 4 * hi; }

__device__ __forceinline__ void qkt(f32x16& p0, f32x16& p1, const char* Ks, const bf16x8* qr, int r32, int hi) {
  p0 = f32x16{}; p1 = f32x16{};
#pragma unroll
  for (int d0 = 0; d0 < 4; ++d0) { const char* kb = Ks + (2 * d0 + hi) * 1024 + r32 * 16;
    bf16x8 b0 = *reinterpret_cast<const bf16x8*>(kb);
    bf16x8 b1 = *reinterpret_cast<const bf16x8*>(kb + 512);
    p0 = __builtin_amdgcn_mfma_f32_32x32x16_bf16(b0, qr[d0], p0, 0, 0, 0);
    p1 = __builtin_amdgcn_mfma_f32_32x32x16_bf16(b1, qr[d0], p1, 0, 0, 0); }
}
__device__ __forceinline__ void glds16(const void* gsrc, unsigned lds_dst) { unsigned keep;
  asm volatile("s_mov_b32 %0, m0\n\ts_mov_b32 m0, %2\n\ts_nop 0\n\tglobal_load_lds_dwordx4 %1, off\n\ts_mov_b32 m0, %0" : "=&s"(keep) : "v"(gsrc), "s"(lds_dst) : "memory"); }
__device__ __forceinline__ int v_rd_base(int lane) { return ((lane & 3) << 3) | (((lane >> 2) & 3) << 6) | (((lane >> 4) & 1) << 5) | (((lane >> 5) & 1) << 8); }
constexpr int v_rd_off(int d0, int ks, int half) { return d0 * 512 + ks * 4096 + half * 2048; }
template <int OFF> __device__ __forceinline__ s16x4 tr_read(int vb) {
  s16x4 r; asm volatile("ds_read_b64_tr_b16 %0, %1 offset:%2" : "=&v"(r) : "v"(vb), "i"(OFF) : "memory"); return r;
}
#define PKV(L, H) (bf16x8){L[0], L[1], L[2], L[3], H[0], H[1], H[2], H[3]}
template <int D0> __device__ __forceinline__ void rd8(int vb, s16x4 (&l)[4], s16x4 (&h)[4]) {
  l[0] = tr_read<v_rd_off(D0, 0, 0)>(vb); h[0] = tr_read<v_rd_off(D0, 0, 1)>(vb); l[1] = tr_read<v_rd_off(D0, 1, 0)>(vb); h[1] = tr_read<v_rd_off(D0, 1, 1)>(vb);
  l[2] = tr_read<v_rd_off(D0, 2, 0)>(vb); h[2] = tr_read<v_rd_off(D0, 2, 1)>(vb); l[3] = tr_read<v_rd_off(D0, 3, 0)>(vb); h[3] = tr_read<v_rd_off(D0, 3, 1)>(vb);
}
__device__ __forceinline__ void mm4(f32x16& od, const s16x4 (&l)[4], const s16x4 (&h)[4], bf16x8 pa0, bf16x8 pa1, bf16x8 pa2, bf16x8 pa3) {
  od = __builtin_amdgcn_mfma_f32_32x32x16_bf16(pa0, PKV(l[0], h[0]), od, 0, 0, 0);
  od = __builtin_amdgcn_mfma_f32_32x32x16_bf16(pa1, PKV(l[1], h[1]), od, 0, 0, 0);
  od = __builtin_amdgcn_mfma_f32_32x32x16_bf16(pa2, PKV(l[2], h[2]), od, 0, 0, 0);
  od = __builtin_amdgcn_mfma_f32_32x32x16_bf16(pa3, PKV(l[3], h[3]), od, 0, 0, 0);
}
__device__ __forceinline__ void pv_d0(f32x16* o, int vb, bf16x8 pa0, bf16x8 pa1, bf16x8 pa2, bf16x8 pa3) {
  s16x4 la[4], ha[4], lb[4], hb[4];
  rd8<0>(vb, la, ha); rd8<1>(vb, lb, hb);
  asm volatile("s_waitcnt lgkmcnt(8)" ::: "memory"); SBAR();
  mm4(o[0], la, ha, pa0, pa1, pa2, pa3); SBAR();
  rd8<2>(vb, la, ha);
  asm volatile("s_waitcnt lgkmcnt(8)" ::: "memory"); SBAR();
  mm4(o[1], lb, hb, pa0, pa1, pa2, pa3); SBAR();
  rd8<3>(vb, lb, hb);
  asm volatile("s_waitcnt lgkmcnt(8)" ::: "memory"); SBAR();
  mm4(o[2], la, ha, pa0, pa1, pa2, pa3); SBAR();
  asm volatile("s_waitcnt lgkmcnt(0)" ::: "memory"); SBAR();
  mm4(o[3], lb, hb, pa0, pa1, pa2, pa3);
}

#define PK4(P, BASE, OUT) do { unsigned a0 = cvt_pk_bf16(P[BASE + 0], P[BASE + 1]), a1 = cvt_pk_bf16(P[BASE + 2], P[BASE + 3]);   \
    unsigned b0 = cvt_pk_bf16(P[BASE + 4], P[BASE + 5]), b1 = cvt_pk_bf16(P[BASE + 6], P[BASE + 7]);                              \
    auto r0 = __builtin_amdgcn_permlane32_swap(a0, b0, false, false); auto r1 = __builtin_amdgcn_permlane32_swap(a1, b1, false, false); \
    u32x4 w = {r0[0], r1[0], r0[1], r1[1]}; OUT = *reinterpret_cast<bf16x8*>(&w); } while (0)
template <int I> __device__ __forceinline__ void finA(const f32x16& P0, const f32x16& P1, float& ps0, float& ps1, unsigned (&cv)[4], bf16x8& pa0, bf16x8& pa1, bf16x8& pa2, bf16x8& pa3) {
  if constexpr (I < 4) { ps0 += P0[4 * I]; ps1 += P0[4 * I + 1]; ps0 += P0[4 * I + 2]; ps1 += P0[4 * I + 3]; }
  else { ps0 += P1[4 * (I - 4)]; ps1 += P1[4 * (I - 4) + 1]; ps0 += P1[4 * (I - 4) + 2]; ps1 += P1[4 * (I - 4) + 3]; }
#define CV4(P, B) do { cv[0] = cvt_pk_bf16(P[B + 0], P[B + 1]); cv[1] = cvt_pk_bf16(P[B + 2], P[B + 3]); cv[2] = cvt_pk_bf16(P[B + 4], P[B + 5]); cv[3] = cvt_pk_bf16(P[B + 6], P[B + 7]); \
    asm volatile("" : "+v"(cv[0]), "+v"(cv[1]), "+v"(cv[2]), "+v"(cv[3])); } while (0)
#define SW2(OUT) do { auto r0 = __builtin_amdgcn_permlane32_swap(cv[0], cv[2], false, false); auto r1 = __builtin_amdgcn_permlane32_swap(cv[1], cv[3], false, false); \
    u32x4 w = {r0[0], r1[0], r0[1], r1[1]}; OUT = *reinterpret_cast<bf16x8*>(&w); asm volatile("" : "+v"(OUT)); } while (0)
  if constexpr (I == 0) CV4(P0, 0);
  if constexpr (I == 1) SW2(pa0);
  if constexpr (I == 2) CV4(P0, 8);
  if constexpr (I == 3) SW2(pa1);
  if constexpr (I == 4) CV4(P1, 0);
  if constexpr (I == 5) SW2(pa2);
  if constexpr (I == 6) CV4(P1, 8);
  if constexpr (I == 7) SW2(pa3);
#undef CV4
#undef SW2
  asm volatile("" : "+v"(ps0), "+v"(ps1));
}
template <int I> __device__ __forceinline__ void expB(f32x16& C0, f32x16& C1) {
  if constexpr (I < 8) { C0[2 * I] = __builtin_amdgcn_exp2f(C0[2 * I]); C0[2 * I + 1] = __builtin_amdgcn_exp2f(C0[2 * I + 1]); asm volatile("" : "+v"(C0)); }
  else { C1[2 * (I - 8)] = __builtin_amdgcn_exp2f(C1[2 * (I - 8)]); C1[2 * (I - 8) + 1] = __builtin_amdgcn_exp2f(C1[2 * (I - 8) + 1]); asm volatile("" : "+v"(C1)); }
}
__device__ __forceinline__ float rowmax16(const f32x16& p) {
  float a = fmaxf(fmaxf(p[0], p[1]), p[2]), b = fmaxf(fmaxf(p[3], p[4]), p[5]);
  a = fmaxf(fmaxf(a, p[6]), p[7]); b = fmaxf(fmaxf(b, p[8]), p[9]);
  a = fmaxf(fmaxf(a, p[10]), p[11]); b = fmaxf(fmaxf(b, p[12]), p[13]);
  a = fmaxf(fmaxf(a, p[14]), p[15]);
  return fmaxf(a, b);
}
__device__ __forceinline__ void rowdecide(float pm0, f32x16& p0, f32x16& p1, f32x16& negm, float& alpha) {
  constexpr float THRL = THR * 1.4426950408889634f;
  float pmax = fmaxf(pm0, rowmax16(p1));
  { auto rr = __builtin_amdgcn_permlane32_swap(__float_as_uint(pmax), __float_as_uint(pmax), false, false);
    pmax = fmaxf(__uint_as_float(rr[0]), __uint_as_float(rr[1])); }
  alpha = 1.f;
  if (__builtin_expect(__any(pmax > THRL), 0)) {
    const float dl = fmaxf(pmax, 0.f);
#pragma unroll
    for (int r = 0; r < 16; ++r) { p0[r] -= dl; p1[r] -= dl; negm[r] -= dl; }
    asm volatile("" : "+v"(negm));
    alpha = __builtin_amdgcn_exp2f(-dl);
  }
}
template <int mp, int ABL = 0> __device__ __forceinline__ void attn_map(int b, int h, int qb, const bf16_t* __restrict__ Q, const bf16_t* __restrict__ K, const bf16_t* __restrict__ V,
                                          bf16_t* __restrict__ O, const float* __restrict__ subln_g, float lam, char* lds) {
  int tid_ = threadIdx.x; asm volatile("" : "+v"(tid_));
  const int tid = tid_, wid = __builtin_amdgcn_readfirstlane(tid >> 6), lane = tid & 63, r32 = lane & 31, hi = lane >> 5;
  char* V_lds = lds + OFF_V; char* K_lds = lds + OFF_K;
  float* ws = (float*)(lds + OFF_WS) + wid * 64; float* li_l = ws; float* al_l = ws + 32;
  unsigned* stash = (unsigned*)(lds + OFF_ST) + wid * 32 * 64 + lane;
  const unsigned lds0 = (unsigned)(uintptr_t)lds;
  const unsigned ko0 = (unsigned)(lane * LD + wid * 8) * 2u;
  unsigned vo0, vo1;
  { const int kkl = (lane >> 2) & 7, cl = 32 * (lane >> 5) + (lane & 3) * 8;
    const int kk0 = 8 * (wid >> 1) + kkl, kk1 = 8 * ((wid + 8) >> 1) + kkl;
    const int key0 = (kk0 & ~0xC) | ((kk0 & 4) << 1) | ((kk0 & 8) >> 1), key1 = (kk1 & ~0xC) | ((kk1 & 4) << 1) | ((kk1 & 8) >> 1);
    vo0 = (unsigned)(key0 * LD + 64 * (wid & 1) + cl) * 2u; vo1 = (unsigned)(key1 * LD + 64 * (wid & 1) + cl) * 2u; }
  const int vb0 = (int)(uintptr_t)V_lds + v_rd_base(lane);
  const size_t qrow0 = (size_t)b * SEQ + (size_t)qb * 256 + wid * QBLK;
  const bf16_t* Vh = V + (size_t)b * NKV * LD + h * 128;
  {
    const bf16_t* Kh = K + (size_t)b * NKV * LD + h * 128 + mp * 64;
    const bf16_t* Qw = Q + (qrow0 + r32) * LD + h * 128 + mp * 64 + hi * 8;
    float l_reg = 0; f32x16 o[4] = {}; bf16x8 qr[4]; float nz_ = 0.f; asm volatile("" : "+v"(nz_)); f32x16 negm; _Pragma("unroll") for (int r = 0; r < 16; ++r) negm[r] = nz_; asm volatile("" : "+v"(negm));
#pragma unroll
    for (int d0 = 0; d0 < 4; ++d0) qr[d0] = __builtin_nontemporal_load(reinterpret_cast<const bf16x8*>(Qw + d0 * 16));
#define DMA(t, slot) do { if constexpr (ABL & 4) break; const char* vt_ = (const char*)Vh + (size_t)(t) * (KVBLK * LD * 2); const char* kt_ = (const char*)Kh + (size_t)(t) * (KVBLK * LD * 2); \
    glds16(kt_ + ko0, (unsigned)__builtin_amdgcn_readfirstlane(lds0 + OFF_K + (slot) * SHM_K + wid * 1024)); \
    glds16(vt_ + vo0, (unsigned)__builtin_amdgcn_readfirstlane(lds0 + OFF_V + (slot) * SHM_V + wid * 1024)); \
    glds16(vt_ + vo1, (unsigned)__builtin_amdgcn_readfirstlane(lds0 + OFF_V + (slot) * SHM_V + (wid + 8) * 1024)); } while (0)
#define WAIT_BAR() asm volatile("s_waitcnt vmcnt(0) lgkmcnt(0)\n\ts_barrier" ::: "memory")
#define RESC(a) do { if (__any((a) < 1.f)) { if (hi == 0) al_l[r32] = (a); asm volatile("s_waitcnt lgkmcnt(0)" ::: "memory"); \
    _Pragma("unroll") for (int d = 0; d < 4; ++d) _Pragma("unroll") for (int r = 0; r < 16; ++r) o[d][r] *= al_l[crow(r, hi)]; } } while (0)
    f32x16 pA0, pA1, pB0, pB1; float alA, alB; bf16x8 pa0, pa1, pa2, pa3;
    int sp = 0, sc_ = 1, sn = 2;
#define ROT() do { const int t_ = sp; sp = sc_; sc_ = sn; sn = t_; } while (0)
#define MF(A_, B_, C_) ((ABL & 2) ? (C_) : __builtin_amdgcn_mfma_f32_32x32x16_bf16(A_, B_, C_, 0, 0, 0))
#define VR(I, L_, H_) do { L_ = tr_read<v_rd_off((I) / 4, (I) % 4, 0)>(vb_); H_ = tr_read<v_rd_off((I) / 4, (I) % 4, 1)>(vb_); } while (0)
#define LDK(D0, H) (*reinterpret_cast<const bf16x8*>(Kp_ + (2 * (D0) + hi) * 1024 + (H) * 512))
#define FINA(I, P0, P1) finA<I>(P0, P1, ps0, ps1, cv_, pa0, pa1, pa2, pa3)
#define STEP(C0, C1, P0, P1, ALP, ALC, DMA_STMT) do { \
      DMA_STMT; \
      const char* Kp_ = K_lds + sc_ * SHM_K + r32 * 16; float ps0 = 0.f, ps1 = 0.f; unsigned cv_[4]; \
      bf16x8 ka0 = LDK(0, 0), ka1 = LDK(0, 1), kb0, kb1; \
      SBAR(); \
      C0 = MF(ka0, qr[0], negm); kb0 = LDK(1, 0); kb1 = LDK(1, 1); FINA(0, P0, P1); SBAR(); \
      C1 = MF(ka1, qr[0], negm); FINA(1, P0, P1); SBAR(); \
      C0 = MF(kb0, qr[1], C0); ka0 = LDK(2, 0); ka1 = LDK(2, 1); FINA(2, P0, P1); SBAR(); \
      C1 = MF(kb1, qr[1], C1); FINA(3, P0, P1); SBAR(); \
      C0 = MF(ka0, qr[2], C0); kb0 = LDK(3, 0); kb1 = LDK(3, 1); FINA(4, P0, P1); SBAR(); \
      C1 = MF(ka1, qr[2], C1); FINA(5, P0, P1); SBAR(); \
      C0 = MF(kb0, qr[3], C0); FINA(6, P0, P1); SBAR(); \
      C1 = MF(kb1, qr[3], C1); FINA(7, P0, P1); float pm0_ = rowmax16(C0); asm volatile("" : "+v"(pm0_)); SBAR(); \
      { float ps = ps0 + ps1; auto rr = __builtin_amdgcn_permlane32_swap(__float_as_uint(ps), __float_as_uint(ps), false, false); \
        ps = __uint_as_float(rr[0]) + __uint_as_float(rr[1]); l_reg = l_reg * (ALP) + ps; } \
      SBAR(); \
      rowdecide(pm0_, C0, C1, negm, ALC); \
      const int vb_ = vb0 + sp * SHM_V; s16x4 vl0, vh0, vl1, vh1, vl2, vh2; \
      VR(0, vl0, vh0); VR(1, vl1, vh1); \
      VR(2, vl2, vh2); asm volatile("s_waitcnt lgkmcnt(4)" ::: "memory"); SBAR(); o[0] = MF(pa0, PKV(vl0, vh0), o[0]); if constexpr (!(ABL & 1)) expB<0>(C0, C1); SBAR(); \
      VR(3, vl0, vh0); asm volatile("s_waitcnt lgkmcnt(4)" ::: "memory"); SBAR(); o[0] = MF(pa1, PKV(vl1, vh1), o[0]); if constexpr (!(ABL & 1)) expB<1>(C0, C1); SBAR(); \
      VR(4, vl1, vh1); asm volatile("s_waitcnt lgkmcnt(4)" ::: "memory"); SBAR(); o[0] = MF(pa2, PKV(vl2, vh2), o[0]); if constexpr (!(ABL & 1)) expB<2>(C0, C1); SBAR(); \
      VR(5, vl2, vh2); asm volatile("s_waitcnt lgkmcnt(4)" ::: "memory"); SBAR(); o[0] = MF(pa3, PKV(vl0, vh0), o[0]); if constexpr (!(ABL & 1)) expB<3>(C0, C1); SBAR(); \
      VR(6, vl0, vh0); asm volatile("s_waitcnt lgkmcnt(4)" ::: "memory"); SBAR(); o[1] = MF(pa0, PKV(vl1, vh1), o[1]); if constexpr (!(ABL & 1)) expB<4>(C0, C1); SBAR(); \
      VR(7, vl1, vh1); asm volatile("s_waitcnt lgkmcnt(4)" ::: "memory"); SBAR(); o[1] = MF(pa1, PKV(vl2, vh2), o[1]); if constexpr (!(ABL & 1)) expB<5>(C0, C1); SBAR(); \
      VR(8, vl2, vh2); asm volatile("s_waitcnt lgkmcnt(4)" ::: "memory"); SBAR(); o[1] = MF(pa2, PKV(vl0, vh0), o[1]); if constexpr (!(ABL & 1)) expB<6>(C0, C1); SBAR(); \
      VR(9, vl0, vh0); asm volatile("s_waitcnt lgkmcnt(4)" ::: "memory"); SBAR(); o[1] = MF(pa3, PKV(vl1, vh1), o[1]); if constexpr (!(ABL & 1)) expB<7>(C0, C1); SBAR(); \
      VR(10, vl1, vh1); asm volatile("s_waitcnt lgkmcnt(4)" ::: "memory"); SBAR(); o[2] = MF(pa0, PKV(vl2, vh2), o[2]); if constexpr (!(ABL & 1)) expB<8>(C0, C1); SBAR(); \
      VR(11, vl2, vh2); asm volatile("s_waitcnt lgkmcnt(4)" ::: "memory"); SBAR(); o[2] = MF(pa1, PKV(vl0, vh0), o[2]); if constexpr (!(ABL & 1)) expB<9>(C0, C1); SBAR(); \
      VR(12, vl0, vh0); asm volatile("s_waitcnt lgkmcnt(4)" ::: "memory"); SBAR(); o[2] = MF(pa2, PKV(vl1, vh1), o[2]); if constexpr (!(ABL & 1)) expB<10>(C0, C1); SBAR(); \
      VR(13, vl1, vh1); asm volatile("s_waitcnt lgkmcnt(4)" ::: "memory"); SBAR(); o[2] = MF(pa3, PKV(vl2, vh2), o[2]); if constexpr (!(ABL & 1)) expB<11>(C0, C1); SBAR(); \
      VR(14, vl2, vh2); asm volatile("s_waitcnt lgkmcnt(4)" ::: "memory"); SBAR(); o[3] = MF(pa0, PKV(vl0, vh0), o[3]); if constexpr (!(ABL & 1)) expB<12>(C0, C1); SBAR(); \
      VR(15, vl0, vh0); asm volatile("s_waitcnt lgkmcnt(4)" ::: "memory"); SBAR(); o[3] = MF(pa1, PKV(vl1, vh1), o[3]); if constexpr (!(ABL & 1)) expB<13>(C0, C1); SBAR(); \
      asm volatile("s_waitcnt lgkmcnt(2)" ::: "memory"); SBAR(); o[3] = MF(pa2, PKV(vl2, vh2), o[3]); if constexpr (!(ABL & 1)) expB<14>(C0, C1); SBAR(); \
      asm volatile("s_waitcnt lgkmcnt(0)" ::: "memory"); SBAR(); o[3] = MF(pa3, PKV(vl0, vh0), o[3]); if constexpr (!(ABL & 1)) expB<15>(C0, C1); SBAR(); \
    } while (0)
    if (wid >= 4) __builtin_amdgcn_s_setprio(1);
    DMA(0, 0); DMA(1, 1); WAIT_BAR();
    { qkt(pA0, pA1, K_lds, qr, r32, hi); rowdecide(rowmax16(pA0), pA0, pA1, negm, alA);
#pragma unroll
      for (int r = 0; r < 16; ++r) { pA0[r] = __builtin_amdgcn_exp2f(pA0[r]); pA1[r] = __builtin_amdgcn_exp2f(pA1[r]); } }
    for (int j = 1; j + 1 < NT; j += 2) {
      STEP(pB0, pB1, pA0, pA1, alA, alB, DMA(j + 1, sn));
      RESC(alB); WAIT_BAR(); ROT();
      STEP(pA0, pA1, pB0, pB1, alB, alA, DMA(j + 2, sn));
      RESC(alA); WAIT_BAR(); ROT();
    }
    STEP(pB0, pB1, pA0, pA1, alA, alB, (void)0);
    RESC(alB);
    { float ps0 = 0.f, ps1 = 0.f; unsigned cv_[4];
      FINA(0, pB0, pB1); FINA(1, pB0, pB1); FINA(2, pB0, pB1); FINA(3, pB0, pB1); FINA(4, pB0, pB1); FINA(5, pB0, pB1); FINA(6, pB0, pB1); FINA(7, pB0, pB1);
      float ps = ps0 + ps1; auto rr = __builtin_amdgcn_permlane32_swap(__float_as_uint(ps), __float_as_uint(ps), false, false);
      ps = __uint_as_float(rr[0]) + __uint_as_float(rr[1]); l_reg = l_reg * alB + ps; }
    SBAR();
    pv_d0(o, vb0 + sc_ * SHM_V, pa0, pa1, pa2, pa3);
#undef STEP
#undef FINA
#undef LDK
#undef VR
#undef MF
#undef ROT
    __builtin_amdgcn_s_setprio(0);
    if (hi == 0) li_l[r32] = l_reg; asm volatile("s_waitcnt lgkmcnt(0)" ::: "memory");
    float rli[16];
#pragma unroll
    for (int r = 0; r < 16; ++r) rli[r] = __builtin_amdgcn_rcpf(li_l[crow(r, hi)]);
    if (mp == 0) {
#pragma unroll
      for (int d0 = 0; d0 < 4; ++d0)
#pragma unroll
        for (int r = 0; r < 16; r += 2) stash[(d0 * 8 + (r >> 1)) * 64] = cvt_pk_bf16(o[d0][r] * rli[r], o[d0][r + 1] * rli[r + 1]);
    } else {
      float ss[16];
#pragma unroll
      for (int r = 0; r < 16; ++r) ss[r] = 0.f;
#pragma unroll
      for (int d0 = 0; d0 < 4; ++d0)
#pragma unroll
        for (int r = 0; r < 16; r += 2) { const unsigned w = stash[(d0 * 8 + (r >> 1)) * 64];
          const float a0 = bf_lo(w) - lam * (o[d0][r] * rli[r]), a1 = bf_hi(w) - lam * (o[d0][r + 1] * rli[r + 1]);
          o[d0][r] = a0; o[d0][r + 1] = a1; ss[r] += a0 * a0; ss[r + 1] += a1 * a1; }
#pragma unroll
      for (int r = 0; r < 16; ++r) { float s = ss[r];
        s += __shfl_xor(s, 1); s += __shfl_xor(s, 2); s += __shfl_xor(s, 4); s += __shfl_xor(s, 8); s += __shfl_xor(s, 16);
        ss[r] = (1.0f - LAM_INIT) / sqrtf(s * (1.0f / 128.0f) + EPS); }
      bf16_t* stg = (bf16_t*)(lds + OFF_ST) + wid * 4096;
#pragma unroll
      for (int d0 = 0; d0 < 4; ++d0) { const float g = subln_g[d0 * 32 + r32];
#pragma unroll
        for (int r = 0; r < 16; ++r) { const unsigned w = cvt_pk_bf16(o[d0][r] * ss[r] * g, 0.f);
          stg[crow(r, hi) * 128 + d0 * 32 + r32] = (bf16_t)(w & 0xffffu); } }
      asm volatile("s_waitcnt lgkmcnt(0)" ::: "memory");
      const char* ob = (const char*)(O + qrow0 * LD + h * 128);
      const unsigned lo = (unsigned)((lane >> 4) * LD + (lane & 15) * 8) * 2u;
#pragma unroll
      for (int i = 0; i < 8; ++i) { const u32x4 v = *(const u32x4*)(stg + (i * 4 + (lane >> 4)) * 128 + (lane & 15) * 8); *(u32x4*)((char*)ob + lo) = v; ob += 4 * LD * 2; }
    }
    __syncthreads();
#undef DMA
#undef WAIT_BAR
#undef RESC
  }
}
__device__ __forceinline__ void attn_unit(int b, int h, int qb, const bf16_t* __restrict__ Q, const bf16_t* __restrict__ K, const bf16_t* __restrict__ V,
                                          bf16_t* __restrict__ O, bf16_t* __restrict__ O2, const float* __restrict__ subln_g, float lam, char* lds) {
  attn_map<0>(b, h, qb, Q, K, V, O, subln_g, lam, lds);
  attn_map<1>(b, h, qb, Q, K, V, O, subln_g, lam, lds);
}
#undef SBAR
}

constexpr int NWAVES = 8, NTHREADS = 512;
constexpr int LDS_BYTES = 147456;
static_assert(att::LDS_BYTES <= LDS_BYTES, "attention LDS");

struct Args {
    const float *x, *c, *ctx, *c_ctx, *w_mod, *b_mod;
    const float *f1_pre, *f1_post, *f1_wg, *f1_wu, *f1_wd;
    const float *mix_pre, *mix_post, *w_in, *lq1, *lk1, *lq2, *lk2, *subln, *conv_w, *w_pa, *w_pb, *w_out;
    const float *f2_pre, *f2_post, *f2_wg, *f2_wu, *f2_wd;
    float* out; unsigned char* ws;
};

__device__ __forceinline__ float wave_sum(float v) {
#pragma unroll
    for (int o = 1; o < 64; o <<= 1) v += __shfl_xor(v, o);
    return v;
}

template <int MAP> __device__ __forceinline__ int wmap(int n) {
    if (MAP == 0) return n;
    if (MAP == 1) return (n >> 7) * 256 + (n & 127);
    if (MAP == 2) return (n >> 7) * 256 + 128 + (n & 127);
    if (n < 2048) { const int rb = n & ~1023, w = n & 1023, head = w >> 7, mm = (w >> 6) & 1, axis = (w >> 5) & 1, half = (w >> 4) & 1, f = w & 15;
        return rb + (head >> 1) * 256 + half * 128 + (head & 1) * 64 + mm * 32 + axis * 16 + f; }
    if (n < 4096) return n;
    if (n < 5120) { const int ch = n - 4096; return 4096 + (ch >> 7) * 256 + (ch & 127); }
    if (n < 6144) { const int ch = n - 5120; return 4096 + (ch >> 7) * 256 + 128 + (ch & 127); }
    return n;
}
template <int MAP> __device__ __forceinline__ void transpose_item(const float* W, int K, int N, bf16_t* WT, LAS float* scr, int item, int lane) {
    const int nblk = N / 32, kb = item / nblk, nb = item % nblk, k0 = 64 * kb, n0 = 32 * nb;
#pragma unroll 8
    for (int i = 0; i < 32; ++i) { const int kk = 2 * i + (lane >> 5); scr[kk * 33 + (lane & 31)] = __builtin_nontemporal_load(W + (size_t)(k0 + kk) * N + n0 + (lane & 31)); }
    asm volatile("s_waitcnt lgkmcnt(0)" ::: "memory");
    const int c = lane & 7;
#pragma unroll
    for (int j = 0; j < 4; ++j) { const int n = (lane >> 3) + 8 * j; const LAS float* s = scr + (8 * c) * 33 + n;
        u32x4 o; o.x = cvt_pk_bf16(s[0 * 33], s[1 * 33]); o.y = cvt_pk_bf16(s[2 * 33], s[3 * 33]); o.z = cvt_pk_bf16(s[4 * 33], s[5 * 33]); o.w = cvt_pk_bf16(s[6 * 33], s[7 * 33]);
        *(u32x4*)(WT + (size_t)wmap<MAP>(n0 + n) * K + k0 + 8 * c) = o; }
    asm volatile("s_waitcnt lgkmcnt(0)" ::: "memory");
}

__device__ __forceinline__ void load_row_f32(const float* p, int lane, f32x4 (&v)[4]) {
#pragma unroll
    for (int j = 0; j < 4; ++j) v[j] = __builtin_nontemporal_load((const f32x4*)(p + 4 * lane + 256 * j));
}
__device__ __forceinline__ void store_row_f32(float* p, int lane, const f32x4 (&v)[4]) {
#pragma unroll
    for (int j = 0; j < 4; ++j) *(f32x4*)(p + 4 * lane + 256 * j) = v[j];
}
__device__ __forceinline__ void load_row_bf16(const bf16_t* p, int lane, f32x4 (&v)[4]) {
#pragma unroll
    for (int j = 0; j < 4; ++j) { const u32x2 w = __builtin_nontemporal_load((const u32x2*)(p + 4 * lane + 256 * j)); v[j] = (f32x4){bf_lo(w.x), bf_hi(w.x), bf_lo(w.y), bf_hi(w.y)}; }
}
__device__ __forceinline__ void store_row_bf16(bf16_t* p, int lane, const f32x4 (&v)[4]) {
#pragma unroll
    for (int j = 0; j < 4; ++j) { u32x2 w; w.x = cvt_pk_bf16(v[j][0], v[j][1]); w.y = cvt_pk_bf16(v[j][2], v[j][3]); *(u32x2*)(p + 4 * lane + 256 * j) = w; }
}
__device__ __forceinline__ float row_rstd(const f32x4 (&v)[4]) {
    float s = 0.f;
#pragma unroll
    for (int j = 0; j < 4; ++j) s += (v[j][0] * v[j][0] + v[j][1] * v[j][1]) + (v[j][2] * v[j][2] + v[j][3] * v[j][3]);
    return 1.0f / sqrtf(wave_sum(s) * (1.0f / DM) + EPS);
}
__device__ __forceinline__ void add_branch(f32x4 (&h)[4], const f32x4 (&y)[4], float coef, const float* gate, const float* g, int lane) {
    const float r = row_rstd(y) * coef;
#pragma unroll
    for (int j = 0; j < 4; ++j) { const f32x4 gt = *(const f32x4*)(gate + 4 * lane + 256 * j), gg = *(const f32x4*)(g + 4 * lane + 256 * j); h[j] = h[j] + gt * (y[j] * r * gg); }
}
__device__ __forceinline__ void norm_mod(const f32x4 (&h)[4], f32x4 (&o)[4], const float* g, const float* shift, const float* scale, int lane) {
    const float r = row_rstd(h);
#pragma unroll
    for (int j = 0; j < 4; ++j) { const f32x4 gg = *(const f32x4*)(g + 4 * lane + 256 * j), sh = *(const f32x4*)(shift + 4 * lane + 256 * j), sc = *(const f32x4*)(scale + 4 * lane + 256 * j);
        o[j] = (h[j] * r * gg) * (1.0f + sc) + sh; }
}

struct PVec { f32x4 v[4]; };
__device__ __forceinline__ PVec load_pvec(const float* p, int lane) { PVec r;
#pragma unroll
    for (int j = 0; j < 4; ++j) r.v[j] = *(const f32x4*)(p + 4 * lane + 256 * j);
    return r; }
__device__ __forceinline__ void add_branch_r(f32x4 (&h)[4], const f32x4 (&y)[4], float coef, const PVec& gg) {
    const float r = row_rstd(y) * coef;
#pragma unroll
    for (int j = 0; j < 4; ++j) h[j] = h[j] + gg.v[j] * (y[j] * r);
}
__device__ __forceinline__ void norm_mod_r(const f32x4 (&h)[4], f32x4 (&o)[4], const PVec& gs1, const PVec& sh) {
    const float r = row_rstd(h);
#pragma unroll
    for (int j = 0; j < 4; ++j) o[j] = (h[j] * r) * gs1.v[j] + sh.v[j];
}
__device__ __forceinline__ PVec pmul(const PVec& a, const PVec& b) { PVec r;
#pragma unroll
    for (int j = 0; j < 4; ++j) r.v[j] = a.v[j] * b.v[j];
    return r; }
__device__ __forceinline__ PVec pmul1p(const PVec& g, const PVec& sc) { PVec r;
#pragma unroll
    for (int j = 0; j < 4; ++j) r.v[j] = g.v[j] * (1.0f + sc.v[j]);
    return r; }

typedef unsigned short bf16;
#define XB_TMO      128
#define XB_XCNT(j)  (256  + 64 * (j))
#define XB_XSUB(j)  (1280 + 64 * (j))
#define XB_XGEN(j)  (2304 + 64 * (j))
#define XB_TOP      3328
#define XB_TOPGEN   3392
#define XCD_BAR_WORDS 3456
#define XB_SPIN_CAP (1u << 18)

__device__ __forceinline__ unsigned xb_ld(unsigned* p)              { return __hip_atomic_load(p, __ATOMIC_RELAXED, __HIP_MEMORY_SCOPE_AGENT); }
__device__ __forceinline__ unsigned xb_add(unsigned* p, unsigned v) { return __hip_atomic_fetch_add(p, v, __ATOMIC_RELAXED, __HIP_MEMORY_SCOPE_AGENT); }
__device__ __forceinline__ unsigned xb_xcc_id() { return (unsigned)__builtin_amdgcn_s_getreg((3 << 11) | 20) & 0xFu; }
#define XB_SPIN(cond, bar) do { unsigned _sp = 0; while (cond) { __builtin_amdgcn_s_sleep(1); \
    if ((++_sp & 255u) == 0u) { if (xb_ld(&(bar)[XB_TMO])) break; if (_sp > XB_SPIN_CAP) { atomicAdd(&(bar)[XB_TMO], 1u); break; } } } } while (0)

struct XcdBarrier {
    unsigned* bar; unsigned x;
    volatile LAS unsigned* st;
};

__device__ __forceinline__ XcdBarrier xcd_barrier_post(unsigned* bar, volatile LAS unsigned* st) {
    XcdBarrier b; b.bar = bar; b.x = xb_xcc_id(); b.st = st;
    if (threadIdx.x == 0) (void)xb_add(&bar[XB_XCNT(b.x)], 1u);
    return b;
}
__device__ __forceinline__ void xcd_barrier_complete(unsigned* bar, unsigned x, unsigned& nloc, unsigned& nx) {
    const unsigned G = gridDim.x * gridDim.y * gridDim.z;
    unsigned sum, cnt, mine, sp = 0u;
    for (;;) {
        sum = 0u; cnt = 0u; mine = 0u;
#pragma unroll
        for (unsigned j = 0; j < 16; ++j) { const unsigned c = xb_ld(&bar[XB_XCNT(j)]); sum += c; cnt += (c > 0u) ? 1u : 0u; mine = (j == x) ? c : mine; }
        if (sum == G) break;
        __builtin_amdgcn_s_sleep(1);
        if ((++sp & 255u) == 0u) { if (xb_ld(&bar[XB_TMO])) break; if (sp > XB_SPIN_CAP) { atomicAdd(&bar[XB_TMO], 1u); break; } }
    }
    nloc = mine > 0u ? mine : 1u; nx = cnt > 0u ? cnt : 1u;
}

__device__ __forceinline__ void xcd_barrier(const XcdBarrier& b) {
    asm volatile("s_waitcnt vmcnt(0)" ::: "memory");
    __syncthreads();
    if (threadIdx.x == 0) {
        unsigned* bar = b.bar;
        __builtin_amdgcn_s_waitcnt(0);
        unsigned nloc = b.st[0], nx = b.st[1];
        if (nloc == 0u) { xcd_barrier_complete(bar, b.x, nloc, nx); b.st[0] = nloc; b.st[1] = nx; }
        const unsigned old = xb_add(&bar[XB_XSUB(b.x)], 1u);
        const unsigned gen = old / nloc;
        if (old + 1u == (gen + 1u) * nloc) {
            __builtin_amdgcn_fence(__ATOMIC_RELEASE, "agent");
            asm volatile("s_waitcnt vmcnt(0)" ::: "memory");
            const unsigned og = xb_add(&bar[XB_TOP], 1u);
            const unsigned tg = og / nx;
            if (og + 1u == (tg + 1u) * nx) xb_add(&bar[XB_TOPGEN], 1u);
            else XB_SPIN(xb_ld(&bar[XB_TOPGEN]) == tg, bar);
            __builtin_amdgcn_fence(__ATOMIC_ACQUIRE, "agent");
            xb_add(&bar[XB_XGEN(b.x)], 1u);
            asm volatile("s_waitcnt vmcnt(0)" ::: "memory");
        } else {
            XB_SPIN(xb_ld(&bar[XB_XGEN(b.x)]) == gen, bar);
            __builtin_amdgcn_fence(__ATOMIC_ACQUIRE, "agent");
            asm volatile("s_waitcnt vmcnt(0)" ::: "memory");
        }
    }
    __syncthreads();
}


#define GRID_SYNC() xcd_barrier(xbar)
__global__ void __launch_bounds__(NTHREADS) fwd_megakernel(Args a) {
    extern __shared__ __attribute__((aligned(16))) unsigned char lds[];
    cg::grid_group grid = cg::this_grid();
    LAS unsigned char* ldsl = (LAS unsigned char*)lds;
    const int tid = threadIdx.x, lane = tid & 63, wave = __builtin_amdgcn_readfirstlane(tid >> 6);
    const int G = gridDim.x, bx = blockIdx.x;
    volatile LAS unsigned* MISC = (volatile LAS unsigned*)(ldsl + LDS_BYTES - 64);
    if (tid < 16) MISC[tid] = 0u;
    __syncthreads();
    XcdBarrier xbar = xcd_barrier_post((unsigned*)a.ws, MISC + 8);
    const int vcu = (G % 8 == 0) ? (bx % 8) * (G / 8) + bx / 8 : bx;
    const int gw = vcu * NWAVES + wave, NGW = G * NWAVES;
    const int xrow0 = (bx & 7) * 2048 + (bx >> 3) * NWAVES + wave, xrow1 = (bx & 7) * 2048 + 2048;
    unsigned char* ws = a.ws;
    float* mods = (float*)(ws + WS_MODS);
    f32x2* rope = (f32x2*)(ws + WS_ROPE);
    bf16_t* WGU1 = (bf16_t*)(ws + WS_WGU1); bf16_t* WD1 = (bf16_t*)(ws + WS_WD1); bf16_t* WGU2 = (bf16_t*)(ws + WS_WGU2); bf16_t* WD2 = (bf16_t*)(ws + WS_WD2);
    bf16_t* WIN = (bf16_t*)(ws + WS_WIN); bf16_t* WPA = (bf16_t*)(ws + WS_WPA); bf16_t* WPB = (bf16_t*)(ws + WS_WPB); bf16_t* WOUT = (bf16_t*)(ws + WS_WOUT);
    bf16_t* Y1 = (bf16_t*)(ws + WS_Y1); bf16_t* R1 = (bf16_t*)(ws + WS_R1); bf16_t* HID = (bf16_t*)(ws + WS_HID);
    bf16_t* Qb = (bf16_t*)(ws + WS_Q); bf16_t* Kb = (bf16_t*)(ws + WS_K); bf16_t* Vb = (bf16_t*)(ws + WS_V); bf16_t* Ob = (bf16_t*)(ws + WS_O);
    bf16_t* BG = (bf16_t*)(ws + WS_BG); bf16_t* Zb = (bf16_t*)(ws + WS_Z); bf16_t* GA = (bf16_t*)(ws + WS_GA); bf16_t* GB = (bf16_t*)a.out;
    bf16_t* Y2 = Zb; bf16_t* Y3 = (bf16_t*)(ws + WS_Y3);

    {
        LAS float* sil = (LAS float*)ldsl;
        LAS float* red = (LAS float*)(ldsl + 12288);
        for (int idx = tid; idx < 3072; idx += NTHREADS) { const int v = idx >> 10, k = idx & 1023; const float cv = (v < 2) ? a.c[v * DM + k] : a.c_ctx[k]; sil[idx] = cv * fast_sigmoid(cv); }
        __syncthreads();
        const bool act = lane < 36; const int j = bx * 36 + (act ? lane : 0), kb = wave * 128;
        float s0 = 0.f, s1 = 0.f, s2 = 0.f;
        if (act) {
#pragma unroll 8
        for (int kk = 0; kk < 128; ++kk) { const float w = __builtin_nontemporal_load(a.w_mod + (size_t)(kb + kk) * NMOD + j); s0 += sil[kb + kk] * w; s1 += sil[1024 + kb + kk] * w; s2 += sil[2048 + kb + kk] * w; }
        }
        red[(wave * 3 + 0) * 64 + lane] = s0; red[(wave * 3 + 1) * 64 + lane] = s1; red[(wave * 3 + 2) * 64 + lane] = s2;
        __syncthreads();
        if (wave < 3 && act) { float s = a.b_mod[j];
#pragma unroll
            for (int w = 0; w < 8; ++w) s += red[(w * 3 + wave) * 64 + lane];
            mods[wave * NMOD + j] = s; }
        __syncthreads();
    }
    if (bx == 144) {
        for (int idx = tid; idx < 128 * 16; idx += NTHREADS) { const int pos = idx >> 4, f = idx & 15;
            const float inv = powf(10000.0f, -(float)f / 16.0f); const float ang = (float)pos * inv;
            rope[idx] = (f32x2){cosf(ang), sinf(ang)}; }
    }
    {
        LAS float* scr = (LAS float*)(ldsl + 16384 + wave * 12288);
        constexpr int I_GU = (DM / 64) * (FF / 32), I_D = (FF / 64) * (DM / 32), I_IN = (DM / 64) * (INW / 32), I_SQ = (DM / 64) * (DM / 32);
        constexpr int NITEMS = 4 * I_GU + 2 * I_D + I_IN + 3 * I_SQ;
        for (int it = gw; it < NITEMS; it += NGW) {
            int r = it;
            if (r < I_GU) { transpose_item<1>(a.f1_wg, DM, FF, WGU1, scr, r, lane); continue; } r -= I_GU;
            if (r < I_GU) { transpose_item<2>(a.f1_wu, DM, FF, WGU1, scr, r, lane); continue; } r -= I_GU;
            if (r < I_D)  { transpose_item<0>(a.f1_wd, FF, DM, WD1, scr, r, lane); continue; } r -= I_D;
            if (r < I_IN) { transpose_item<3>(a.w_in, DM, INW, WIN, scr, r, lane); continue; } r -= I_IN;
            if (r < I_SQ) { transpose_item<0>(a.w_pa, DM, DM, WPA, scr, r, lane); continue; } r -= I_SQ;
            if (r < I_SQ) { transpose_item<0>(a.w_pb, DM, DM, WPB, scr, r, lane); continue; } r -= I_SQ;
            if (r < I_SQ) { transpose_item<0>(a.w_out, DM, DM, WOUT, scr, r, lane); continue; } r -= I_SQ;
            if (r < I_GU) { transpose_item<1>(a.f2_wg, DM, FF, WGU2, scr, r, lane); continue; } r -= I_GU;
            if (r < I_GU) { transpose_item<2>(a.f2_wu, DM, FF, WGU2, scr, r, lane); continue; } r -= I_GU;
            transpose_item<0>(a.f2_wd, FF, DM, WD2, scr, r, lane);
        }
    }
    GRID_SYNC();
    grid.sync();

    for (int trip = 0; trip < 9; ++trip) { const int row = trip < 8 ? xrow0 + 256 * trip : ML + gw; if (row >= MT) break;
        const float* src = row < ML ? a.x + (size_t)row * DM : a.ctx + (size_t)(row - ML) * DM;
        const float* md = mods + (row < ML ? (row >> 13) : 2) * NMOD;
        f32x4 h[4], o[4]; load_row_f32(src, lane, h);
        norm_mod(h, o, a.f1_pre, md + 0 * DM, md + 1 * DM, lane);
        store_row_bf16(R1 + (size_t)row * DM, lane, o);
    }
    GRID_SYNC();

    unsigned* ctxctr = (unsigned*)(ws + 32768);
    { pg8::Gemm g{R1, WGU1, MT, 2 * FF, DM}; pg8::CtxGUOrder S{bx}; pg8::EpiSwiGLU E{HID, FF};
      pg8::gemm_phase(ldsl, g, S, E);
      if (bx >= 8 && bx < 52) { asm volatile("s_waitcnt vmcnt(0)" ::: "memory"); __syncthreads();
        if (tid == 0) { __builtin_amdgcn_fence(__ATOMIC_RELEASE, "agent"); asm volatile("s_waitcnt vmcnt(0)" ::: "memory");
                        __hip_atomic_fetch_add(ctxctr, 1u, __ATOMIC_RELAXED, __HIP_MEMORY_SCOPE_AGENT); } } }
    { pg8::Gemm g{R1, WGU1, ML, 2 * FF, DM}; pg8::LatGUOrder S; S.S.init(ML, 2 * FF, G, bx); S.c = bx; pg8::EpiSwiGLU E{HID, FF};
      pg8::gemm_phase(ldsl, g, S, E); }
    if (bx < 8) {
        if (tid == 0) { while (__hip_atomic_load(ctxctr, __ATOMIC_RELAXED, __HIP_MEMORY_SCOPE_AGENT) < 44u) __builtin_amdgcn_s_sleep(8); }
        __syncthreads(); __builtin_amdgcn_fence(__ATOMIC_ACQUIRE, "agent"); asm volatile("s_waitcnt vmcnt(0)" ::: "memory");
        pg8::Gemm g{HID, WD1, MT, DM, FF}; pg8::CtxDownOrder S{bx}; pg8::EpiPlain E{Y1, DM};
        pg8::gemm_phase(ldsl, g, S, E); }
    GRID_SYNC();
    if (wave < 2) {
        const int row = ML + bx * 2 + wave; const float* md = mods + 2 * NMOD;
        f32x4 h[4], y[4], o[4]; load_row_f32(a.ctx + (size_t)(row - ML) * DM, lane, h); load_row_bf16(Y1 + (size_t)row * DM, lane, y);
        add_branch(h, y, 0.5f, md + 2 * DM, a.f1_post, lane);
        norm_mod(h, o, a.mix_pre, md + 3 * DM, md + 4 * DM, lane);
        store_row_bf16(R1 + (size_t)row * DM, lane, o);
    }
    { pg8::Gemm g{HID, WD1, ML, DM, FF}; pg8::StaticOrder S; S.init(ML, DM, G, bx); pg8::EpiPlain E{Y1, DM};
      pg8::gemm_phase(ldsl, g, S, E); }
    GRID_SYNC();

    if (bx < 16) {
        pg8::Gemm g{R1, WIN, MT, 3072, DM}; pg8::CtxKVOrder S{bx}; pg8::EpiQKV E{Qb, Kb, Vb, rope};
        pg8::gemm_phase(ldsl, g, S, E);
    } else {
        for (int rl = ((bx >> 3) - 2) * NWAVES + wave; rl < 2048; rl += 30 * NWAVES) { const int row = (bx & 7) * 2048 + rl;
            const float* md = mods + (row >> 13) * NMOD;
            f32x4 h[4], y[4], o[4]; load_row_f32(a.x + (size_t)row * DM, lane, h); load_row_bf16(Y1 + (size_t)row * DM, lane, y);
            add_branch(h, y, 0.5f, md + 2 * DM, a.f1_post, lane);
            norm_mod(h, o, a.mix_pre, md + 3 * DM, md + 4 * DM, lane);
            store_row_bf16(R1 + (size_t)row * DM, lane, o);
        }
    }
    GRID_SYNC();

    { pg8::Gemm g{R1, WIN, ML, 3072, DM}; pg8::StaticOrder S; S.init(ML, 3072, G, bx); pg8::EpiQKV E{Qb, Kb, Vb, rope};
      pg8::gemm_phase(ldsl, g, S, E); }
    GRID_SYNC();

    {
        float d1 = 0.f, d2 = 0.f;
        for (int i = 0; i < 64; ++i) { d1 += a.lq1[i] * a.lk1[i]; d2 += a.lq2[i] * a.lk2[i]; }
        const float lam = expf(d1) - expf(d2) + LAM_INIT;
        for (int u = vcu; u < NB * 8 * (SEQ / 256); u += G) {
            const int bh = u >> 5, qb = u & 31;
            att::attn_unit(bh >> 3, bh & 7, qb, Qb, Kb, Vb, Ob, (bf16_t*)a.out, a.subln, lam, (char*)lds);
        }
    }
    GRID_SYNC();

    { pg8::Gemm g{R1, WIN + (size_t)3072 * DM, ML, 5120, DM}; pg8::StaticOrder S; S.init(ML, 5120, G, bx); pg8::EpiRest E{BG, Zb, GA, GB};
      pg8::gemm_phase(ldsl, g, S, E); }
    GRID_SYNC();

    for (int row = xrow0; row < xrow1; row += 256) {
        const int t = row & (SEQ - 1);
#pragma unroll
        for (int j = 0; j < 2; ++j) { const int col = 8 * lane + 512 * j;
            const u32x4 zc = *(const u32x4*)(Zb + (size_t)row * DM + col);
            u32x4 zp = (u32x4){0, 0, 0, 0}, zn = (u32x4){0, 0, 0, 0};
            if (t > 0) zp = *(const u32x4*)(Zb + (size_t)(row - 1) * DM + col);
            if (t < SEQ - 1) zn = *(const u32x4*)(Zb + (size_t)(row + 1) * DM + col);
            const u32x4 bg = __builtin_nontemporal_load((const u32x4*)(BG + (size_t)row * DM + col));
            const f32x4 w0a = *(const f32x4*)(a.conv_w + col), w0b = *(const f32x4*)(a.conv_w + col + 4);
            const f32x4 w1a = *(const f32x4*)(a.conv_w + DM + col), w1b = *(const f32x4*)(a.conv_w + DM + col + 4);
            const f32x4 w2a = *(const f32x4*)(a.conv_w + 2 * DM + col), w2b = *(const f32x4*)(a.conv_w + 2 * DM + col + 4);
            f32x4 ra, rb;
            ra[0] = bf_lo(bg.x) * (w0a[0] * bf_lo(zp.x) + w1a[0] * bf_lo(zc.x) + w2a[0] * bf_lo(zn.x));
            ra[1] = bf_hi(bg.x) * (w0a[1] * bf_hi(zp.x) + w1a[1] * bf_hi(zc.x) + w2a[1] * bf_hi(zn.x));
            ra[2] = bf_lo(bg.y) * (w0a[2] * bf_lo(zp.y) + w1a[2] * bf_lo(zc.y) + w2a[2] * bf_lo(zn.y));
            ra[3] = bf_hi(bg.y) * (w0a[3] * bf_hi(zp.y) + w1a[3] * bf_hi(zc.y) + w2a[3] * bf_hi(zn.y));
            rb[0] = bf_lo(bg.z) * (w0b[0] * bf_lo(zp.z) + w1b[0] * bf_lo(zc.z) + w2b[0] * bf_lo(zn.z));
            rb[1] = bf_hi(bg.z) * (w0b[1] * bf_hi(zp.z) + w1b[1] * bf_hi(zc.z) + w2b[1] * bf_hi(zn.z));
            rb[2] = bf_lo(bg.w) * (w0b[2] * bf_lo(zp.w) + w1b[2] * bf_lo(zc.w) + w2b[2] * bf_lo(zn.w));
            rb[3] = bf_hi(bg.w) * (w0b[3] * bf_hi(zp.w) + w1b[3] * bf_hi(zc.w) + w2b[3] * bf_hi(zn.w));
            *(u32x4*)(BG + (size_t)row * DM + col) = pg8::pack8(ra, rb); }
    }
    GRID_SYNC();

    { pg8::Gemm g{Ob, WPA, ML, DM, DM}; pg8::StaticOrder S; S.init(ML, DM, G, bx); pg8::EpiGate<0> E{GA, GB};
      pg8::gemm_phase(ldsl, g, S, E); }
    { pg8::Gemm g{BG, WPB, ML, DM, DM}; pg8::StaticOrder S; S.init(ML, DM, G, bx); pg8::EpiGate<1> E{GA, GB};
      pg8::gemm_phase(ldsl, g, S, E); }
    GRID_SYNC();
    { pg8::Gemm g{GB, WOUT, ML, DM, DM}; pg8::StaticOrder S; S.init(ML, DM, G, bx); pg8::EpiPlain E{Y2, DM};
      pg8::gemm_phase(ldsl, g, S, E); }
    GRID_SYNC();

    { const float* md = mods + ((bx & 7) >> 2) * NMOD;
      const PVec g1 = pmul(load_pvec(md + 2 * DM, lane), load_pvec(a.f1_post, lane)), g2 = pmul(load_pvec(md + 5 * DM, lane), load_pvec(a.mix_post, lane));
      const PVec gs = pmul1p(load_pvec(a.f2_pre, lane), load_pvec(md + 7 * DM, lane)), sh = load_pvec(md + 6 * DM, lane);
      for (int row = xrow0; row < xrow1; row += 256) {
        f32x4 h[4], y[4], y2[4], o[4]; load_row_f32(a.x + (size_t)row * DM, lane, h); load_row_bf16(Y1 + (size_t)row * DM, lane, y); load_row_bf16(Y2 + (size_t)row * DM, lane, y2);
        add_branch_r(h, y, 0.5f, g1);
        add_branch_r(h, y2, 1.0f, g2);
        store_row_f32(a.out + (size_t)row * DM, lane, h);
        norm_mod_r(h, o, gs, sh);
        store_row_bf16(R1 + (size_t)row * DM, lane, o);
      } }
    GRID_SYNC();

    { pg8::Gemm g{R1, WGU2, ML, 2 * FF, DM}; pg8::StaticOrder S; S.init(ML, 2 * FF, G, bx); pg8::EpiSwiGLU E{HID, FF};
      pg8::gemm_phase(ldsl, g, S, E); }
    GRID_SYNC();
    { pg8::Gemm g{HID, WD2, ML, DM, FF}; pg8::StaticOrder S; S.init(ML, DM, G, bx); pg8::EpiPlain E{Y3, DM};
      pg8::gemm_phase(ldsl, g, S, E); }
    GRID_SYNC();

    { const float* md = mods + ((bx & 7) >> 2) * NMOD;
      const PVec g3 = pmul(load_pvec(md + 8 * DM, lane), load_pvec(a.f2_post, lane));
      for (int row = xrow0; row < xrow1; row += 256) {
        f32x4 h[4], y[4]; load_row_f32(a.out + (size_t)row * DM, lane, h); load_row_bf16(Y3 + (size_t)row * DM, lane, y);
        add_branch_r(h, y, 0.5f, g3);
        store_row_f32(a.out + (size_t)row * DM, lane, h);
      } }
}

extern "C" void kernel_launch(void* const* d_in, const int* in_sizes, int n_in, void* d_out, int out_size, void* d_ws, size_t ws_size, hipStream_t stream) {
    static int grid = 0;
    if (grid == 0) {
        int dev = 0, cus = 0, per_cu = 0;
        hipGetDevice(&dev);
        hipDeviceGetAttribute(&cus, hipDeviceAttributeMultiprocessorCount, dev);
        if (hipFuncSetAttribute((const void*)fwd_megakernel, hipFuncAttributeMaxDynamicSharedMemorySize, LDS_BYTES) != hipSuccess) { fprintf(stderr, "hipFuncSetAttribute failed\n"); }
        hipOccupancyMaxActiveBlocksPerMultiprocessor(&per_cu, (const void*)fwd_megakernel, NTHREADS, LDS_BYTES);
        (void)hipGetLastError();
        if (per_cu < 1) { fprintf(stderr, "occupancy query says %d blocks/CU\n", per_cu); per_cu = 1; }
        grid = cus;
        if (n_in != 28 || ws_size < 256 * MiB) fprintf(stderr, "unexpected n_in %d / ws %zu\n", n_in, ws_size);
    }
    (void)hipMemsetAsync(d_ws, 0, 49152, stream);
    Args a{};
    const float** p = (const float**)&a;
    for (int i = 0; i < 28; ++i) p[i] = (const float*)d_in[i];
    a.out = (float*)d_out; a.ws = (unsigned char*)d_ws;
    void* args[] = {&a};
    hipError_t e = hipLaunchCooperativeKernel((const void*)fwd_megakernel, dim3(grid), dim3(NTHREADS), args, LDS_BYTES, stream);
    if (e != hipSuccess) fprintf(stderr, "cooperative launch failed: %s (grid %d)\n", hipGetErrorString(e), grid);
}
```
